# Optimizing an MI355X kernel written in HIP

```python
import jax, jax.numpy as jnp
from jax import lax
import numpy as np

D_MODEL = 2048
BATCH = 4
SEQ = 4096
DEPTH = 2

GRID_W = 64
NA_HEADS = 16
NA_HEAD_DIM = 64
NA_WIDTH = NA_HEADS * NA_HEAD_DIM
NA_KH_MAX = 8
NA_KW = 16
MLA_HEADS = 8
MLA_NOPE = 128
MLA_ROPE = 64
MLA_V = 128
MLA_Q_LORA = 448
MLA_KV_LORA = 160
MLA_WIDTH = MLA_HEADS * MLA_V
ROPE_THETA = 10000.0
Q_BLOCK = 128
FNET_GROUPS = 4
FNET_GROUP_DIM = 256
FNET_WIDTH = FNET_GROUPS * FNET_GROUP_DIM
N_BRANCHES = 3
BRANCH_WIDTH = NA_WIDTH
IN_SPLITS = (3 * NA_WIDTH, MLA_Q_LORA, MLA_KV_LORA, MLA_ROPE, FNET_WIDTH, N_BRANCHES * D_MODEL)
IN_COLS = sum(IN_SPLITS)
N_EXPERTS = 16
EXPERT_FF = 2048
CAPACITY_FACTOR = 2
RMS_EPS = 1e-6
NEG_INF = -1e30

kernel_name = "hybrid_na_mla_fnet_ecmoe_encoder"


def rmsnorm(x, g):
    xf = x.astype(jnp.float32)
    y = xf * lax.rsqrt(jnp.mean(xf * xf, axis=-1, keepdims=True) + RMS_EPS)
    return (y * g.astype(jnp.float32)).astype(x.dtype)


def rope_tables(seq):
    pos = jnp.arange(seq, dtype=jnp.float32)
    inv = 1.0 / (ROPE_THETA ** (jnp.arange(0, MLA_ROPE, 2, dtype=jnp.float32) / MLA_ROPE))
    ang = pos[:, None] * inv[None, :]
    return jnp.cos(ang), jnp.sin(ang)


def apply_rope(x, cos, sin):
    xf = x.astype(jnp.float32)
    x1, x2 = jnp.split(xf, 2, axis=-1)
    return jnp.concatenate([x1 * cos - x2 * sin, x2 * cos + x1 * sin], axis=-1).astype(x.dtype)


def neighbourhood_attention(q, k, v, rpb):
    B, S, H, dh = q.shape
    rows = S // GRID_W
    kh = min(NA_KH_MAX, rows)
    qg = q.reshape(B, rows, GRID_W, H, dh)
    kg = k.reshape(B, rows, GRID_W, H, dh)
    vg = v.reshape(B, rows, GRID_W, H, dh)
    cols = np.arange(GRID_W)
    col_start = np.clip(cols - NA_KW // 2, 0, GRID_W - NA_KW)
    col_valid = (cols[None, :] >= col_start[:, None]) & (cols[None, :] < col_start[:, None] + NA_KW)
    col_idx = np.clip(cols[None, :] - cols[:, None] + NA_KW - 1, 0, 2 * NA_KW - 2)
    scale = NA_HEAD_DIM ** -0.5

    def row_block(args):
        r, qr = args
        start = jnp.clip(r - kh // 2, 0, rows - kh)
        kb = lax.dynamic_slice_in_dim(kg, start, kh, axis=1)
        vb = lax.dynamic_slice_in_dim(vg, start, kh, axis=1)
        dr = start + jnp.arange(kh) - r + NA_KH_MAX - 1
        bias = rpb[:, dr[None, :, None], col_idx[:, None, :]]
        s = jnp.einsum('bqhd,bijhd->bhqij', qr, kb).astype(jnp.float32) * scale + bias.astype(jnp.float32)
        s = jnp.where(col_valid[:, None, :], s, NEG_INF)
        p = jax.nn.softmax(s.reshape(B, H, GRID_W, kh * GRID_W), axis=-1)
        p = p.reshape(B, H, GRID_W, kh, GRID_W).astype(v.dtype)
        return jnp.einsum('bhqij,bijhd->bqhd', p, vb)

    out = lax.map(row_block, (jnp.arange(rows), jnp.moveaxis(qg, 1, 0)))
    return jnp.moveaxis(out, 0, 1).reshape(B, S, H * dh)


def latent_attention(c_q, c_kv, k_rope, w_uq, q_norm, w_ukv, kv_norm, cos, sin):
    B, S, _ = c_q.shape
    q = (rmsnorm(c_q, q_norm) @ w_uq).reshape(B, S, MLA_HEADS, MLA_NOPE + MLA_ROPE)
    q_nope, q_pe = q[..., :MLA_NOPE], q[..., MLA_NOPE:]
    q_pe = apply_rope(q_pe, cos[:, None, :], sin[:, None, :])
    kv = (rmsnorm(c_kv, kv_norm) @ w_ukv).reshape(B, S, MLA_HEADS, MLA_NOPE + MLA_V)
    k_nope, v = kv[..., :MLA_NOPE], kv[..., MLA_NOPE:]
    k_pe = apply_rope(k_rope, cos, sin)
    nb = S // Q_BLOCK
    scale = (MLA_NOPE + MLA_ROPE) ** -0.5

    def to_blocks(t):
        return jnp.moveaxis(t.reshape(B, nb, Q_BLOCK, *t.shape[2:]), 1, 0)

    def q_block(args):
        qn, qp = args
        s = (jnp.einsum('bqhd,bkhd->bhqk', qn, k_nope)
             + jnp.einsum('bqhr,bkr->bhqk', qp, k_pe)).astype(jnp.float32) * scale
        p = jax.nn.softmax(s, axis=-1).astype(v.dtype)
        return jnp.einsum('bhqk,bkhd->bqhd', p, v)

    out = lax.map(q_block, (to_blocks(q_nope), to_blocks(q_pe)))
    return jnp.moveaxis(out, 0, 1).reshape(B, S, MLA_HEADS * MLA_V)


def fourier_mix(u):
    B, S, _ = u.shape
    g = u.reshape(B, S, FNET_GROUPS, FNET_GROUP_DIM).astype(jnp.float32)
    f = jnp.fft.fft2(g, axes=(1, 3), norm='ortho').real
    return f.astype(u.dtype).reshape(B, S, FNET_WIDTH)


def hybrid_mixer(xn, w_in, b_gate, w_uq, q_norm, w_ukv, kv_norm, rpb, w_branch, w_o, cos, sin):
    B, S, _ = xn.shape
    proj = xn @ w_in
    offsets = [int(o) for o in np.cumsum(IN_SPLITS)[:-1]]
    qkv_na, c_q, c_kv, k_rope, u_f, gate_logits = jnp.split(proj, offsets, axis=-1)
    q_na, k_na, v_na = [t.reshape(B, S, NA_HEADS, NA_HEAD_DIM) for t in jnp.split(qkv_na, 3, axis=-1)]
    y_na = neighbourhood_attention(q_na, k_na, v_na, rpb)
    y_mla = latent_attention(c_q, c_kv, k_rope, w_uq, q_norm, w_ukv, kv_norm, cos, sin)
    y_f = fourier_mix(u_f)
    gates = jax.nn.sigmoid((gate_logits + b_gate).astype(jnp.float32)).astype(xn.dtype)
    gates = gates.reshape(B, S, N_BRANCHES, D_MODEL)
    merged = (gates[:, :, 0] * (y_na @ w_branch[0])
              + gates[:, :, 1] * (y_mla @ w_branch[1])
              + gates[:, :, 2] * (y_f @ w_branch[2]))
    return merged @ w_o


def expert_choice_ffn(xn, w_router, w_g, w_u, w_d):
    B, S, D = xn.shape
    cap = CAPACITY_FACTOR * S // N_EXPERTS
    aff = jax.nn.softmax((xn @ w_router).astype(jnp.float32), axis=-1)
    gate, idx = lax.top_k(jnp.swapaxes(aff, 1, 2), cap)
    xe = jax.vmap(lambda xb, ib: xb[ib])(xn, idx)
    h = jax.nn.silu(jnp.einsum('becd,edf->becf', xe, w_g)) * jnp.einsum('becd,edf->becf', xe, w_u)
    ye = jnp.einsum('becf,efd->becd', h, w_d) * gate[..., None].astype(xn.dtype)
    return jax.vmap(lambda yb, ib: jnp.zeros((S, D), yb.dtype).at[ib.reshape(-1)].add(yb.reshape(-1, D)))(ye, idx)


def setup_inputs(seed: int = 0) -> dict:
    key = jax.random.key(seed)
    ks = jax.random.split(key, 20)

    def w(k, shape, fan_in):
        return jax.random.normal(k, shape, jnp.float32) * fan_in ** -0.5

    def gain(k, shape):
        return 1.0 + 0.05 * jax.random.normal(k, shape, jnp.float32)

    return {
        'x': jax.random.normal(ks[0], (BATCH, SEQ, D_MODEL), jnp.float32),
        'w_in': w(ks[1], (DEPTH, D_MODEL, IN_COLS), D_MODEL),
        'b_gate': 0.01 * jax.random.normal(ks[2], (DEPTH, N_BRANCHES * D_MODEL), jnp.float32),
        'w_uq': w(ks[3], (DEPTH, MLA_Q_LORA, MLA_HEADS * (MLA_NOPE + MLA_ROPE)), MLA_Q_LORA),
        'q_norm': gain(ks[4], (DEPTH, MLA_Q_LORA)),
        'w_ukv': w(ks[5], (DEPTH, MLA_KV_LORA, MLA_HEADS * (MLA_NOPE + MLA_V)), MLA_KV_LORA),
        'kv_norm': gain(ks[6], (DEPTH, MLA_KV_LORA)),
        'na_rpb': 0.1 * jax.random.normal(ks[7], (DEPTH, NA_HEADS, 2 * NA_KH_MAX - 1, 2 * NA_KW - 1), jnp.float32),
        'w_branch': w(ks[8], (DEPTH, N_BRANCHES, BRANCH_WIDTH, D_MODEL), BRANCH_WIDTH),
        'w_o': w(ks[9], (DEPTH, D_MODEL, D_MODEL), D_MODEL),
        'norm_mix': gain(ks[10], (DEPTH, D_MODEL)),
        'norm_moe': gain(ks[11], (DEPTH, D_MODEL)),
        'w_router': w(ks[12], (DEPTH, D_MODEL, N_EXPERTS), D_MODEL),
        'w_exp_gate': w(ks[13], (DEPTH, N_EXPERTS, D_MODEL, EXPERT_FF), D_MODEL),
        'w_exp_up': w(ks[14], (DEPTH, N_EXPERTS, D_MODEL, EXPERT_FF), D_MODEL),
        'w_exp_down': w(ks[15], (DEPTH, N_EXPERTS, EXPERT_FF, D_MODEL), EXPERT_FF),
        'norm_final': gain(ks[16], (D_MODEL,)),
    }


def reference(x, w_in, b_gate, w_uq, q_norm, w_ukv, kv_norm, na_rpb, w_branch, w_o,
              norm_mix, norm_moe, w_router, w_exp_gate, w_exp_up, w_exp_down, norm_final):
    cos, sin = rope_tables(x.shape[1])
    h = x
    for l in range(DEPTH):
        h = h + hybrid_mixer(rmsnorm(h, norm_mix[l]), w_in[l], b_gate[l], w_uq[l], q_norm[l],
                             w_ukv[l], kv_norm[l], na_rpb[l], w_branch[l], w_o[l], cos, sin)
        h = h + expert_choice_ffn(rmsnorm(h, norm_moe[l]), w_router[l], w_exp_gate[l],
                                  w_exp_up[l], w_exp_down[l])
    return rmsnorm(h, norm_final)
```

```cpp
#include <hip/hip_runtime.h>
#include <cstdio>
#include <cstdint>

#ifndef MK_DEBUG
#define MK_DEBUG 0
#endif

#define GAS __attribute__((address_space(1)))
#define LAS __attribute__((address_space(3)))
typedef unsigned short bf16_t;
typedef short bf16x8 __attribute__((ext_vector_type(8)));
typedef short s16x4 __attribute__((ext_vector_type(4)));
typedef float f32x4 __attribute__((ext_vector_type(4)));
typedef float f32x2 __attribute__((ext_vector_type(2)));
typedef float f32x16 __attribute__((ext_vector_type(16)));
typedef unsigned u32x4 __attribute__((ext_vector_type(4)));
typedef unsigned u32x2 __attribute__((ext_vector_type(2)));

constexpr int DM = 2048, NB = 4, SEQ = 4096, T = NB * SEQ, DEPTH = 2;
constexpr int IN_COLS = 10912, NIN = 11008;
constexpr int QL = 448, QLP = 512, KVL = 160, KVLP = 256;
constexpr int NE = 16, FF = 2048, CAP = 512, ROWS_E = NB * CAP;
constexpr float RMS_EPS = 1e-6f;
constexpr float LOG2E = 1.4426950408889634f;

constexpr size_t MiB = 1u << 20;
constexpr size_t WS_CTL = 0, CTL_ZERO_BYTES = 64 * 1024;
constexpr size_t WS_DBG = 512 * 1024;
constexpr size_t WS_ROPEC = 1 * MiB, WS_ROPES = WS_ROPEC + 512 * 1024;
constexpr size_t WS_WCH = 2 * MiB;
constexpr size_t WS_AFF = 3 * MiB;
constexpr size_t WS_MROWS = 4 * MiB, WS_MGATE = WS_MROWS + 256 * 1024;
constexpr size_t WS_SLOT = 5 * MiB;
constexpr size_t WS_SSQQ = 6 * MiB, WS_SSQKV = WS_SSQQ + 512 * 1024;
constexpr size_t WS_ADFT = 8 * MiB;
constexpr size_t WS_W = 72 * MiB, W_LAYER = 450 * MiB;
constexpr size_t WO_IN = 0, WO_UQ = 43 * MiB, WO_UKV = WO_UQ + 3 * MiB / 2, WO_BR = WO_UKV + 1 * MiB, WO_O = WO_BR + 12 * MiB, WO_GU = WO_O + 8 * MiB, WO_D = WO_GU + 256 * MiB;
static_assert(WO_D + 128 * MiB <= W_LAYER, "weights");
constexpr size_t WS_H = 972 * MiB;
constexpr size_t WS_XN = 1100 * MiB;
constexpr size_t WS_QNA = 1164 * MiB, WS_KNA = 1196 * MiB, WS_VT = 1228 * MiB, WS_UF = 1260 * MiB;
constexpr size_t WS_GATES = 1292 * MiB;
constexpr size_t WS_CQ = 1484 * MiB, WS_CKV = 1500 * MiB, WS_KPE = 1508 * MiB;
constexpr size_t WS_ZT = 1512 * MiB;
constexpr size_t WS_QMLA = 1576 * MiB, WS_KVMLA = 1624 * MiB;
constexpr size_t WS_YNA = 1688 * MiB, WS_YMLA = 1720 * MiB, WS_YF = 1752 * MiB;
constexpr size_t WS_MPART = 1784 * MiB;
constexpr size_t WS_MERGED = 1912 * MiB;
constexpr size_t WS_HMOE = 1164 * MiB;
constexpr size_t WS_YE = 1292 * MiB;
constexpr size_t WS_END = 1976 * MiB;

constexpr int RING_BYTES = 131072;
constexpr int MISC_OFF = 135168;
constexpr int LDS_BYTES = 147456;

__device__ __forceinline__ float bf2f(bf16_t b) { return __uint_as_float(((unsigned)b) << 16); }
__device__ __forceinline__ unsigned f2bf(float f) { unsigned u = __float_as_uint(f); return (u + 0x7fffu + ((u >> 16) & 1u)) >> 16; }
__device__ __forceinline__ unsigned cvt_pk_bf16(float lo, float hi) { unsigned r; asm volatile("s_nop 0\n\tv_cvt_pk_bf16_f32 %0, %1, %2" : "=v"(r) : "v"(lo), "v"(hi)); return r; }
__device__ __forceinline__ float wave_sum(float v) {
#pragma unroll
    for (int o = 1; o < 64; o <<= 1) v += __shfl_xor(v, o);
    return v;
}
#define LDS_WAIT() asm volatile("s_waitcnt lgkmcnt(0)" ::: "memory")
#define VM_WAIT() asm volatile("s_waitcnt vmcnt(0)" ::: "memory")

#define XB_TMO      128
#define XB_XCNT(j)  (256  + 64 * (j))
#define XB_XSUB(j)  (1280 + 64 * (j))
#define XB_XGEN(j)  (2304 + 64 * (j))
#define XB_TOP      3328
#define XB_TOPGEN   3392
#define XCD_BAR_WORDS 3456
#define XB_SPIN_CAP (1u << 18)
__device__ __forceinline__ unsigned xb_ld(unsigned* p)              { return __hip_atomic_load(p, __ATOMIC_RELAXED, __HIP_MEMORY_SCOPE_AGENT); }
__device__ __forceinline__ unsigned xb_add(unsigned* p, unsigned v) { return __hip_atomic_fetch_add(p, v, __ATOMIC_RELAXED, __HIP_MEMORY_SCOPE_AGENT); }
__device__ __forceinline__ unsigned xb_xcc_id() { return (unsigned)__builtin_amdgcn_s_getreg((3 << 11) | 20) & 0xFu; }
#define XB_SPIN(cond, bar) do { unsigned _sp = 0; while (cond) { __builtin_amdgcn_s_sleep(1); \
    if ((++_sp & 255u) == 0u) { if (xb_ld(&(bar)[XB_TMO])) break; if (_sp > XB_SPIN_CAP) { atomicAdd(&(bar)[XB_TMO], 1u); break; } } } } while (0)
struct XcdBarrier { unsigned* bar; unsigned x; volatile LAS unsigned* st; };
__device__ __forceinline__ XcdBarrier xcd_barrier_post(unsigned* bar, volatile LAS unsigned* st) {
    XcdBarrier b; b.bar = bar; b.x = xb_xcc_id(); b.st = st;
    if (threadIdx.x == 0) (void)xb_add(&bar[XB_XCNT(b.x)], 1u);
    return b;
}
__device__ __forceinline__ void xcd_barrier_complete(unsigned* bar, unsigned x, unsigned& nloc, unsigned& nx) {
    const unsigned G = gridDim.x * gridDim.y * gridDim.z;
    unsigned sum, cnt, mine, sp = 0u;
    for (;;) {
        sum = 0u; cnt = 0u; mine = 0u;
#pragma unroll
        for (unsigned j = 0; j < 16; ++j) { const unsigned c = xb_ld(&bar[XB_XCNT(j)]); sum += c; cnt += (c > 0u) ? 1u : 0u; mine = (j == x) ? c : mine; }
        if (sum == G) break;
        __builtin_amdgcn_s_sleep(1);
        if ((++sp & 255u) == 0u) { if (xb_ld(&bar[XB_TMO])) break; if (sp > XB_SPIN_CAP) { atomicAdd(&bar[XB_TMO], 1u); break; } }
    }
    nloc = mine > 0u ? mine : 1u; nx = cnt > 0u ? cnt : 1u;
}
template <bool FIRST> __device__ __forceinline__ void xcd_barrier(const XcdBarrier& b) {
    asm volatile("s_waitcnt vmcnt(0)" ::: "memory");
    __syncthreads();
    if (threadIdx.x == 0) {
        unsigned* bar = b.bar;
        __builtin_amdgcn_s_waitcnt(0);
        unsigned nloc = b.st[0], nx = b.st[1];
        if constexpr (FIRST) { if (nloc == 0u) { xcd_barrier_complete(bar, b.x, nloc, nx); b.st[0] = nloc; b.st[1] = nx; } }
        else if (nloc == 0u) { atomicAdd(&bar[XB_TMO], 1u); nloc = 1u; nx = 1u; }
        const unsigned old = xb_add(&bar[XB_XSUB(b.x)], 1u);
        const unsigned gen = old / nloc;
        if (old + 1u == (gen + 1u) * nloc) {
            __builtin_amdgcn_fence(__ATOMIC_RELEASE, "agent");
            asm volatile("s_waitcnt vmcnt(0)" ::: "memory");
            const unsigned og = xb_add(&bar[XB_TOP], 1u);
            const unsigned tg = og / nx;
            if (og + 1u == (tg + 1u) * nx) xb_add(&bar[XB_TOPGEN], 1u);
            else XB_SPIN(xb_ld(&bar[XB_TOPGEN]) == tg, bar);
            __builtin_amdgcn_fence(__ATOMIC_ACQUIRE, "agent");
            xb_add(&bar[XB_XGEN(b.x)], 1u);
            asm volatile("s_waitcnt vmcnt(0)" ::: "memory");
        } else {
            XB_SPIN(xb_ld(&bar[XB_XGEN(b.x)]) == gen, bar);
            __builtin_amdgcn_fence(__ATOMIC_ACQUIRE, "agent");
            asm volatile("s_waitcnt vmcnt(0)" ::: "memory");
        }
    }
    __syncthreads();
}

namespace pg8 {
constexpr int BM = 256, BK = 64, HALF = 128, HTB = HALF * BK * 2, STAGE_BYTES = 8 * HTB, NXCD = 8, WGM = 8;
__host__ __device__ __forceinline__ int lds_byte(int r, int c) { const int st = (r >> 4) * 2 + (c >> 5), rr = r & 15, cc = c & 31, ob = rr * 64 + cc * 2; return st * 1024 + (ob ^ (((ob >> 9) & 1) << 5)); }
__host__ __device__ __forceinline__ void stage_rc(int b, int& R, int& C) { const int st = b / 1024, sb = b % 1024, swz = sb ^ (((sb >> 9) & 1) << 5); R = (st >> 1) * 16 + swz / 64; C = (st & 1) * 32 + (swz % 64) / 2; }
__host__ __device__ __forceinline__ int perm32(int rho) { const int n = rho >> 4, i = rho & 15; return 8 * (i >> 2) + 4 * n + (i & 3); }

struct Unit { const char* A; const char* B; const int* rows; int orow, ocol, aux; };
struct Shape { int K, lda, ldb; unsigned bhalf; };

__device__ __forceinline__ void tile_order(int L, int nM, int nN, int& pm, int& pn) {
    const int nwg = nM * nN; int wgid = L;
    { const int q = nwg / NXCD, r = nwg % NXCD, xcd = wgid % NXCD, off = wgid / NXCD; wgid = (xcd < r ? xcd * (q + 1) : r * (q + 1) + (xcd - r) * q) + off; }
    const int nig = WGM * nN, gid = wgid / nig, fm = gid * WGM, gsz = (nM - fm) < WGM ? (nM - fm) : WGM;
    pm = fm + ((wgid % nig) % gsz); pn = (wgid % nig) / gsz;
}

template <class Epi, class Sched, bool GATHER>
__device__ __forceinline__ void gemm_phase(LAS unsigned char* lds, const Shape g, const Sched& S, const Epi& E) {
    int tid_ = threadIdx.x; asm volatile("" : "+v"(tid_));
    const int tid = tid_, wid = __builtin_amdgcn_readfirstlane(tid >> 6), lane = tid & 63, wr = wid >> 2, wc = wid & 3, fr = lane & 15, fq = lane >> 4;
    int Kop = g.K; asm volatile("" : "+s"(Kop));
    const int K = Kop, nt = K / BK;
    unsigned vAc[2][2], vAn[2][2], vB[2]; int Rr[2], Cc[2];
#pragma unroll
    for (int i = 0; i < 2; ++i) { int R, C; stage_rc(tid * 16 + i * 8192, R, C); const int Rb = (R & ~31) + perm32(R & 31);
        Rr[i] = R; Cc[i] = C;
        vAc[0][i] = (unsigned)(R * g.lda + C) * 2u; vAc[1][i] = vAc[0][i];
        vB[i] = (unsigned)(Rb * g.ldb + C) * 2u; }
    const size_t hA = GATHER ? (size_t)0 : (size_t)HALF * g.lda * 2, hB = (size_t)g.bhalf;
    const size_t kstep = (size_t)(BK * 2);
    const unsigned ldsw = (unsigned)wid * 1024u;
    const int aoff = lds_byte(wr * 64 + fr, fq * 8), boff = lds_byte(wc * 32 + fr, fq * 8);
#define PG8_SA(b, h) (((b) * 2 + (h)) * HTB)
#define PG8_SB(b, h) ((4 + (b) * 2 + (h)) * HTB)
#define PG8_STAGE(bufoff, gbase, voff) do { _Pragma("unroll") for (int _i = 0; _i < 2; ++_i) \
        __builtin_amdgcn_global_load_lds((const unsigned*)((const char*)(gbase) + (voff)[_i]), (LAS unsigned*)(lds + (bufoff) + ldsw + _i * 8192), 16, 0, 0); } while (0)
#define PG8_LDA(dst, b, h) do { _Pragma("unroll") for (int m = 0; m < 4; ++m) _Pragma("unroll") for (int k = 0; k < 2; ++k) dst[m][k] = *(const LAS bf16x8*)(lds + PG8_SA(b, h) + aoff + m * 2048 + k * 1024); } while (0)
#define PG8_LDB(dst, b, h) do { _Pragma("unroll") for (int n = 0; n < 2; ++n) _Pragma("unroll") for (int k = 0; k < 2; ++k) dst[n][k] = *(const LAS bf16x8*)(lds + PG8_SB(b, h) + boff + n * 2048 + k * 1024); } while (0)
#define PG8_MMA(ai, bj, At, Bt) do { __builtin_amdgcn_s_setprio(1); _Pragma("unroll") for (int m = 0; m < 4; ++m) _Pragma("unroll") for (int n = 0; n < 2; ++n) _Pragma("unroll") for (int k = 0; k < 2; ++k) \
        acc[ai][bj][m][n] = __builtin_amdgcn_mfma_f32_16x16x32_bf16(Bt[n][k], At[m][k], acc[ai][bj][m][n], 0, 0, 0); __builtin_amdgcn_s_setprio(0); } while (0)
#define PG8_WAIT_V(n) asm volatile("s_waitcnt vmcnt(" #n ")" ::: "memory")
#define PG8_WAIT_L(n) asm volatile("s_waitcnt lgkmcnt(" #n ")" ::: "memory")
#define PG8_BAR __builtin_amdgcn_s_barrier()
#define PG8_SCHED __builtin_amdgcn_sched_barrier(0)
    Unit cur, nxt; int ui = 0;
    if (!S.next(0, cur)) return;
    if constexpr (GATHER) {
#pragma unroll
        for (int h = 0; h < 2; ++h)
#pragma unroll
            for (int i = 0; i < 2; ++i) vAc[h][i] = (unsigned)cur.rows[h * HALF + Rr[i]] * (unsigned)(g.lda * 2) + (unsigned)Cc[i] * 2u;
    }
    f32x4 acc[2][2][4][2];
#pragma unroll
    for (int a = 0; a < 2; ++a)
#pragma unroll
        for (int b = 0; b < 2; ++b)
#pragma unroll
            for (int m = 0; m < 4; ++m)
#pragma unroll
                for (int n = 0; n < 2; ++n) acc[a][b][m][n] = (f32x4){0.f, 0.f, 0.f, 0.f};
    bf16x8 At[4][2], B0[2][2], B1[2][2];
    const char* cA = cur.A; const char* cB = cur.B;
    PG8_STAGE(PG8_SB(0, 0), cB, vB); PG8_STAGE(PG8_SB(0, 1), cB + hB, vB); PG8_STAGE(PG8_SA(0, 0), cA, vAc[0]); PG8_STAGE(PG8_SA(0, 1), cA + hA, vAc[1]);
    if (wr == 1) PG8_BAR;
    PG8_WAIT_V(2); PG8_BAR;
    PG8_STAGE(PG8_SB(1, 0), cB + kstep, vB); PG8_STAGE(PG8_SA(1, 0), cA + kstep, vAc[0]); PG8_STAGE(PG8_SB(1, 1), cB + hB + kstep, vB);
    PG8_WAIT_V(6); PG8_BAR;
    for (;;) {
        const bool has_next = S.next(ui + 1, nxt);
        const char* nA = has_next ? nxt.A : cA; const char* nB = has_next ? nxt.B : cB;
#pragma unroll
        for (int h = 0; h < 2; ++h)
#pragma unroll
            for (int i = 0; i < 2; ++i) vAn[h][i] = vAc[h][i];
        if constexpr (GATHER) { if (has_next) {
#pragma unroll
            for (int h = 0; h < 2; ++h)
#pragma unroll
                for (int i = 0; i < 2; ++i) vAn[h][i] = (unsigned)nxt.rows[h * HALF + Rr[i]] * (unsigned)(g.lda * 2) + (unsigned)Cc[i] * 2u; } }
#pragma unroll 1
        for (int t = 0; t < nt; t += 2) {
            const bool last = (t == nt - 2);
            const char* a1 = cA + (size_t)(t + 1) * kstep;
            const char* a2 = last ? nA : cA + (size_t)(t + 2) * kstep; const char* b2 = last ? nB : cB + (size_t)(t + 2) * kstep;
            const char* a3 = a2 + kstep; const char* b3 = b2 + kstep;
            unsigned vA2[2][2];
#pragma unroll
            for (int h = 0; h < 2; ++h)
#pragma unroll
                for (int i = 0; i < 2; ++i) vA2[h][i] = (GATHER && last) ? vAn[h][i] : vAc[h][i];
            PG8_LDB(B0, 0, 0); PG8_LDB(B1, 0, 1); PG8_SCHED; PG8_LDA(At, 0, 0); PG8_STAGE(PG8_SA(1, 1), a1 + hA, vAc[1]);
            PG8_WAIT_V(8); PG8_WAIT_L(0); PG8_BAR; PG8_MMA(0, 0, At, B0); PG8_MMA(0, 1, At, B1); PG8_BAR; PG8_SCHED;
            PG8_LDA(At, 0, 1); PG8_STAGE(PG8_SB(0, 0), b2, vB); PG8_STAGE(PG8_SB(0, 1), b2 + hB, vB); PG8_STAGE(PG8_SA(0, 0), a2, vA2[0]);
            PG8_WAIT_V(8); PG8_WAIT_L(0); PG8_BAR; PG8_MMA(1, 0, At, B0); PG8_MMA(1, 1, At, B1); PG8_BAR; PG8_SCHED;
            PG8_LDB(B0, 1, 0); PG8_LDB(B1, 1, 1); PG8_SCHED; PG8_LDA(At, 1, 0); PG8_STAGE(PG8_SA(0, 1), a2 + hA, vA2[1]);
            PG8_WAIT_V(8); PG8_WAIT_L(0); PG8_BAR; PG8_MMA(0, 0, At, B0); PG8_MMA(0, 1, At, B1); PG8_BAR; PG8_SCHED;
            PG8_LDA(At, 1, 1); PG8_STAGE(PG8_SB(1, 0), b3, vB); PG8_STAGE(PG8_SB(1, 1), b3 + hB, vB); PG8_STAGE(PG8_SA(1, 0), a3, vA2[0]);
            PG8_WAIT_V(8); PG8_WAIT_L(0); PG8_BAR; PG8_MMA(1, 0, At, B0); PG8_MMA(1, 1, At, B1); PG8_BAR; PG8_SCHED;
        }
        if (wr == 0) PG8_BAR;
        E(acc, cur, wr, wc, fr, fq);
        if (!has_next) break;
#pragma unroll
        for (int a = 0; a < 2; ++a)
#pragma unroll
            for (int b = 0; b < 2; ++b)
#pragma unroll
                for (int m = 0; m < 4; ++m)
#pragma unroll
                    for (int n = 0; n < 2; ++n) acc[a][b][m][n] = (f32x4){0.f, 0.f, 0.f, 0.f};
        cur = nxt; cA = nA; cB = nB; ++ui;
#pragma unroll
        for (int h = 0; h < 2; ++h)
#pragma unroll
            for (int i = 0; i < 2; ++i) vAc[h][i] = vAn[h][i];
        if (wr == 1) PG8_BAR;
    }
    PG8_WAIT_V(0);
    PG8_BAR;
#undef PG8_SA
#undef PG8_SB
#undef PG8_STAGE
#undef PG8_LDA
#undef PG8_LDB
#undef PG8_MMA
#undef PG8_WAIT_V
#undef PG8_WAIT_L
#undef PG8_BAR
#undef PG8_SCHED
}
}
using pg8::Unit; using pg8::Shape;

struct SchedGrid {
    const char* A; const char* B; size_t a_tile, b_tile; int nM, nN, G, c;
    __device__ __forceinline__ bool next(int i, Unit& u) const {
        const int L = i * G + c; if (L >= nM * nN) return false;
        int pm, pn; pg8::tile_order(L, nM, nN, pm, pn);
        u.A = A + (size_t)pm * a_tile; u.B = B + (size_t)pn * b_tile; u.rows = nullptr; u.orow = pm * 256; u.ocol = pn * 256; u.aux = 0; return true;
    }
};
struct SchedBranch {
    const char* A[3]; const char* B; int G, c;
    __device__ __forceinline__ bool next(int i, Unit& u) const {
        const int round = i / 3, br = i - round * 3; const int L = round * G + c; if (L >= 512) return false;
        int pm, pn; pg8::tile_order(L, 64, 8, pm, pn);
        const char* a = br == 0 ? A[0] : (br == 1 ? A[1] : A[2]);
        u.A = a + (size_t)pm * 256 * 1024 * 2; u.B = B + ((size_t)br * 2048 + (size_t)pn * 256) * 1024 * 2; u.rows = nullptr; u.orow = pm * 256; u.ocol = pn * 256; u.aux = br; return true;
    }
};
struct SchedF1 {
    const char* Wch; const char* uf; int G, c;
    __device__ __forceinline__ bool next(int i, Unit& u) const {
        const int L = i * G + c; if (L >= 512) return false;
        const int pn = L & 15, pm = (L >> 4) & 1, g = (L >> 5) & 3, b = L >> 7;
        u.A = Wch + (size_t)pm * 256 * 256 * 2; u.B = uf + (((size_t)b * SEQ + pn * 256) * 1024 + g * 256) * 2; u.rows = nullptr; u.orow = pm; u.ocol = pn * 256; u.aux = b * 4 + g; return true;
    }
};
struct SchedDft {
    const char* adft; const char* zt; int c;
    __device__ __forceinline__ bool next(int i, Unit& u) const {
        if (i > 0 || c >= 256) return false;
        const int pn = c & 3, pm = (c >> 2) & 15, b = c >> 6;
        u.A = adft + (size_t)pm * 256 * 8192 * 2; u.B = zt + ((size_t)b * 1024 + pn * 256) * 8192 * 2; u.rows = nullptr; u.orow = b * SEQ + pm * 256; u.ocol = pn * 256; u.aux = 0; return true;
    }
};
struct SchedMoe1 {
    const char* xn; const int* rows; const char* wgu; int G, c;
    __device__ __forceinline__ bool next(int i, Unit& u) const {
        const int L = i * G + c; if (L >= 2048) return false;
        const int pm = L & 7, pn = (L >> 3) & 15, e = L >> 7;
        u.A = xn; u.rows = rows + e * ROWS_E + pm * 256; u.B = wgu + (size_t)e * (2 * FF * DM * 2) + (size_t)pn * 128 * DM * 2; u.orow = e * ROWS_E + pm * 256; u.ocol = pn * 128; u.aux = e; return true;
    }
};
struct SchedMoe2 {
    const char* hm; const char* wd; int G, c;
    __device__ __forceinline__ bool next(int i, Unit& u) const {
        const int L = i * G + c; if (L >= 1024) return false;
        const int pm = L & 7, pn = (L >> 3) & 7, e = L >> 6;
        u.A = hm + ((size_t)e * ROWS_E + pm * 256) * FF * 2; u.B = wd + ((size_t)e * DM + pn * 256) * FF * 2; u.rows = nullptr; u.orow = e * ROWS_E + pm * 256; u.ocol = pn * 256; u.aux = e; return true;
    }
};

#define EPI_ARGS const f32x4 (&acc)[2][2][4][2], const Unit& u, int wr, int wc, int fr, int fq
#define FOR_AI_M _Pragma("unroll") for (int ai = 0; ai < 2; ++ai) _Pragma("unroll") for (int m = 0; m < 4; ++m)
__device__ __forceinline__ u32x4 pack8(const f32x4 a, const f32x4 b) { u32x4 w; w.x = cvt_pk_bf16(a[0], a[1]); w.y = cvt_pk_bf16(a[2], a[3]); w.z = cvt_pk_bf16(b[0], b[1]); w.w = cvt_pk_bf16(b[2], b[3]); return w; }
__device__ __forceinline__ void unpack8(const u32x4 w, f32x4& a, f32x4& b) {
    a[0] = __uint_as_float(w.x << 16); a[1] = __uint_as_float(w.x & 0xffff0000u); a[2] = __uint_as_float(w.y << 16); a[3] = __uint_as_float(w.y & 0xffff0000u);
    b[0] = __uint_as_float(w.z << 16); b[1] = __uint_as_float(w.z & 0xffff0000u); b[2] = __uint_as_float(w.w << 16); b[3] = __uint_as_float(w.w & 0xffff0000u); }
__device__ __forceinline__ void store_tile_bf16(EPI_ARGS, bf16_t* O, int ldc, int orow, int ocol, float sc) {
    const int row0 = orow + wr * 64 + fr, col0 = ocol + wc * 32 + 8 * fq;
    FOR_AI_M { bf16_t* rowp = O + (size_t)(row0 + ai * 128 + m * 16) * ldc + col0;
#pragma unroll
        for (int bj = 0; bj < 2; ++bj) *(u32x4*)(rowp + bj * 128) = pack8(acc[ai][bj][m][0] * sc, acc[ai][bj][m][1] * sc); }
}
__device__ __forceinline__ void rope8(f32x4& v0, f32x4& v1, const float* ropec, const float* ropes, int s, int jj0) {
    const f32x4 c = *(const f32x4*)(ropec + s * 32 + jj0), sn = *(const f32x4*)(ropes + s * 32 + jj0);
    f32x4 o0, o1;
    o0[0] = v0[0] * c[0] - v0[1] * sn[0]; o0[1] = v0[1] * c[0] + v0[0] * sn[0];
    o0[2] = v0[2] * c[1] - v0[3] * sn[1]; o0[3] = v0[3] * c[1] + v0[2] * sn[1];
    o1[0] = v1[0] * c[2] - v1[1] * sn[2]; o1[1] = v1[1] * c[2] + v1[0] * sn[2];
    o1[2] = v1[2] * c[3] - v1[3] * sn[3]; o1[3] = v1[3] * c[3] + v1[2] * sn[3];
    v0 = o0; v1 = o1;
}

struct EpiInProj {
    bf16_t *Qna, *Kna, *Vt, *uf, *gates, *cq, *ckv, *kpe; const float *bgate, *ropec, *ropes; float *ssqq, *ssqkv;
    __device__ __forceinline__ void operator()(EPI_ARGS) const {
        const int pn = u.ocol >> 8;
        if (pn < 4) { store_tile_bf16(acc, u, wr, wc, fr, fq, Qna, 1024, u.orow, u.ocol, 0.125f); return; }
        if (pn < 8) { store_tile_bf16(acc, u, wr, wc, fr, fq, Kna, 1024, u.orow, u.ocol - 1024, 1.f); return; }
        if (pn < 12) {
            const int b = u.orow >> 12, s0 = (u.orow & 4095) + wr * 64 + fr;
#pragma unroll
            for (int bj = 0; bj < 2; ++bj) { const int head = (pn - 8) * 4 + bj * 2 + (wc >> 1), d0 = 32 * (wc & 1) + 8 * fq;
                bf16_t* vp = Vt + ((size_t)(b * 16 + head) * 64 + d0) * SEQ + s0;
                FOR_AI_M {
#pragma unroll
                    for (int n = 0; n < 2; ++n)
#pragma unroll
                        for (int j = 0; j < 4; ++j) vp[(size_t)(4 * n + j) * SEQ + ai * 128 + m * 16] = (bf16_t)f2bf(acc[ai][bj][m][n][j]); } }
            return; }
        if (pn < 16) { store_tile_bf16(acc, u, wr, wc, fr, fq, uf, 1024, u.orow, u.ocol - 3072, 1.f); return; }
        if (pn < 40) {
            const int row0 = u.orow + wr * 64 + fr, col0 = (u.ocol - 4096) + wc * 32 + 8 * fq;
#pragma unroll
            for (int bj = 0; bj < 2; ++bj) { const f32x4 b0 = *(const f32x4*)(bgate + col0 + bj * 128), b1 = *(const f32x4*)(bgate + col0 + bj * 128 + 4);
                FOR_AI_M { f32x4 v0 = acc[ai][bj][m][0] + b0, v1 = acc[ai][bj][m][1] + b1;
#pragma unroll
                    for (int j = 0; j < 4; ++j) { v0[j] = __builtin_amdgcn_rcpf(1.f + __expf(-v0[j])); v1[j] = __builtin_amdgcn_rcpf(1.f + __expf(-v1[j])); }
                    *(u32x4*)(gates + (size_t)(row0 + ai * 128 + m * 16) * 6144 + col0 + bj * 128) = pack8(v0, v1); } }
            return; }
        if (pn < 42) {
            store_tile_bf16(acc, u, wr, wc, fr, fq, cq, QLP, u.orow, u.ocol - 10240, 1.f);
            const int row0 = u.orow + wr * 64 + fr, slot = (pn - 40) * 4 + wc;
            FOR_AI_M { float s = 0.f;
#pragma unroll
                for (int bj = 0; bj < 2; ++bj)
#pragma unroll
                    for (int n = 0; n < 2; ++n) { const f32x4 x = acc[ai][bj][m][n]; s += (x[0] * x[0] + x[1] * x[1]) + (x[2] * x[2] + x[3] * x[3]); }
                s += __shfl_xor(s, 16); s += __shfl_xor(s, 32);
                if (fq == 0) ssqq[(size_t)(row0 + ai * 128 + m * 16) * 8 + slot] = s; }
            return; }
        {
            const int row0 = u.orow + wr * 64 + fr, cl = wc * 32 + 8 * fq;
            FOR_AI_M { const int row = row0 + ai * 128 + m * 16; float s = 0.f;
                *(u32x4*)(ckv + (size_t)row * KVLP + cl) = pack8(acc[ai][0][m][0], acc[ai][0][m][1]);
                { const f32x4 x = acc[ai][0][m][0], y = acc[ai][0][m][1]; s += (x[0] * x[0] + x[1] * x[1]) + (x[2] * x[2] + x[3] * x[3]) + (y[0] * y[0] + y[1] * y[1]) + (y[2] * y[2] + y[3] * y[3]); }
                if (wc == 0) {
                    *(u32x4*)(ckv + (size_t)row * KVLP + 128 + cl) = pack8(acc[ai][1][m][0], acc[ai][1][m][1]);
                    const f32x4 x = acc[ai][1][m][0], y = acc[ai][1][m][1]; s += (x[0] * x[0] + x[1] * x[1]) + (x[2] * x[2] + x[3] * x[3]) + (y[0] * y[0] + y[1] * y[1]) + (y[2] * y[2] + y[3] * y[3]);
                } else {
                    *(u32x4*)(ckv + (size_t)row * KVLP + 128 + cl) = pack8(acc[ai][1][m][0] * 0.f, acc[ai][1][m][1] * 0.f);
                    if (wc <= 2) { f32x4 v0 = acc[ai][1][m][0], v1 = acc[ai][1][m][1]; const int kc = cl - 32;
                        rope8(v0, v1, ropec, ropes, row & 4095, kc >> 1);
                        *(u32x4*)(kpe + (size_t)row * 64 + kc) = pack8(v0, v1); }
                }
                s += __shfl_xor(s, 16); s += __shfl_xor(s, 32);
                if (fq == 0) ssqkv[(size_t)row * 4 + wc] = s; }
        }
    }
};
struct EpiQup {
    bf16_t* qmla; const float *ssqq, *ropec, *ropes;
    __device__ __forceinline__ void operator()(EPI_ARGS) const {
        const int row0 = u.orow + wr * 64 + fr, col0 = u.ocol + wc * 32 + 8 * fq;
        FOR_AI_M { const int row = row0 + ai * 128 + m * 16;
            const f32x4 p0 = *(const f32x4*)(ssqq + (size_t)row * 8), p1 = *(const f32x4*)(ssqq + (size_t)row * 8 + 4);
            const float ss = ((p0[0] + p0[1]) + (p0[2] + p0[3])) + ((p1[0] + p1[1]) + (p1[2] + p1[3]));
            const float rstd = 1.0f / sqrtf(ss * (1.f / QL) + RMS_EPS);
#pragma unroll
            for (int bj = 0; bj < 2; ++bj) { const int col = col0 + bj * 128, c8 = col % 192;
                f32x4 v0 = acc[ai][bj][m][0] * rstd, v1 = acc[ai][bj][m][1] * rstd;
                if (c8 >= 128) rope8(v0, v1, ropec, ropes, row & 4095, (c8 - 128) >> 1);
                *(u32x4*)(qmla + (size_t)row * 1536 + col) = pack8(v0, v1); } }
    }
};
struct EpiKVup {
    bf16_t* kv; const float* ssqkv;
    __device__ __forceinline__ void operator()(EPI_ARGS) const {
        const int row0 = u.orow + wr * 64 + fr, col0 = u.ocol + wc * 32 + 8 * fq;
        FOR_AI_M { const int row = row0 + ai * 128 + m * 16;
            const f32x4 p0 = *(const f32x4*)(ssqkv + (size_t)row * 4);
            const float rstd = 1.0f / sqrtf(((p0[0] + p0[1]) + (p0[2] + p0[3])) * (1.f / KVL) + RMS_EPS);
#pragma unroll
            for (int bj = 0; bj < 2; ++bj) *(u32x4*)(kv + (size_t)row * 2048 + col0 + bj * 128) = pack8(acc[ai][bj][m][0] * rstd, acc[ai][bj][m][1] * rstd); }
    }
};
struct EpiF1 {
    bf16_t* zt;
    __device__ __forceinline__ void operator()(EPI_ARGS) const {
        const int b = u.aux >> 2, g = u.aux & 3;
        store_tile_bf16(acc, u, wr, wc, fr, fq, zt + ((size_t)b * 1024 + g * 256) * 8192 + (size_t)u.orow * SEQ, 8192, 0, u.ocol, 1.f);
    }
};
struct EpiBf16 {
    bf16_t* O; int ldc;
    __device__ __forceinline__ void operator()(EPI_ARGS) const { store_tile_bf16(acc, u, wr, wc, fr, fq, O, ldc, u.orow, u.ocol, 1.f); }
};
struct EpiBranch {
    const bf16_t* gates; float* mpart; bf16_t* merged;
    __device__ __forceinline__ void operator()(EPI_ARGS) const {
        const int br = u.aux, row0 = u.orow + wr * 64 + fr, col0 = u.ocol + wc * 32 + 8 * fq;
        FOR_AI_M { const size_t row = (size_t)(row0 + ai * 128 + m * 16);
#pragma unroll
            for (int bj = 0; bj < 2; ++bj) { const int col = col0 + bj * 128;
                f32x4 g0, g1; unpack8(*(const u32x4*)(gates + row * 6144 + br * 2048 + col), g0, g1);
                f32x4 v0 = acc[ai][bj][m][0] * g0, v1 = acc[ai][bj][m][1] * g1;
                float* mp = mpart + row * 2048 + col;
                if (br > 0) { v0 += *(const f32x4*)mp; v1 += *(const f32x4*)(mp + 4); }
                if (br < 2) { *(f32x4*)mp = v0; *(f32x4*)(mp + 4) = v1; }
                else *(u32x4*)(merged + row * 2048 + col) = pack8(v0, v1); } }
    }
};
struct EpiResid {
    const float* base; float* h;
    __device__ __forceinline__ void operator()(EPI_ARGS) const {
        const int row0 = u.orow + wr * 64 + fr, col0 = u.ocol + wc * 32 + 8 * fq;
        FOR_AI_M { const size_t off = (size_t)(row0 + ai * 128 + m * 16) * 2048 + col0;
#pragma unroll
            for (int bj = 0; bj < 2; ++bj) { const f32x4 b0 = *(const f32x4*)(base + off + bj * 128), b1 = *(const f32x4*)(base + off + bj * 128 + 4);
                *(f32x4*)(h + off + bj * 128) = b0 + acc[ai][bj][m][0]; *(f32x4*)(h + off + bj * 128 + 4) = b1 + acc[ai][bj][m][1]; } }
    }
};
struct EpiSwiglu {
    bf16_t* hm;
    __device__ __forceinline__ void operator()(EPI_ARGS) const {
        const int row0 = u.orow + wr * 64 + fr, col0 = u.ocol + wc * 32 + 8 * fq;
        FOR_AI_M { f32x4 v0, v1;
#pragma unroll
            for (int j = 0; j < 4; ++j) { const float g0 = acc[ai][0][m][0][j], g1 = acc[ai][0][m][1][j];
                v0[j] = g0 * __builtin_amdgcn_rcpf(1.f + __expf(-g0)) * acc[ai][1][m][0][j]; v1[j] = g1 * __builtin_amdgcn_rcpf(1.f + __expf(-g1)) * acc[ai][1][m][1][j]; }
            *(u32x4*)(hm + (size_t)(row0 + ai * 128 + m * 16) * FF + col0) = pack8(v0, v1); }
    }
};
struct EpiDown {
    bf16_t* ye; const float* mgate;
    __device__ __forceinline__ void operator()(EPI_ARGS) const {
        const int row0 = u.orow + wr * 64 + fr, col0 = u.ocol + wc * 32 + 8 * fq;
        FOR_AI_M { const int row = row0 + ai * 128 + m * 16; const float gt = mgate[row];
#pragma unroll
            for (int bj = 0; bj < 2; ++bj) *(u32x4*)(ye + (size_t)row * DM + col0 + bj * 128) = pack8(acc[ai][bj][m][0] * gt, acc[ai][bj][m][1] * gt); }
    }
};

struct Args { const float* in[17]; float* out; unsigned char* ws; int ph_lo, ph_hi; };
enum { I_X = 0, I_WIN, I_BGATE, I_WUQ, I_QNORM, I_WUKV, I_KVNORM, I_RPB, I_WBR, I_WO, I_NMIX, I_NMOE, I_WROUTER, I_WG, I_WU, I_WD, I_NFINAL };
struct Frame { LAS unsigned char* lds; int tid, lane, wave, vcu, G; };

__device__ __forceinline__ int map_col(int map, int n) {
    if (map == 0) return n;
    if (map == 1) {
        if (n < 3072) return n;
        if (n < 3520) return 10240 + (n - 3072);
        if (n < 3680) return 10752 + (n - 3520);
        if (n < 3744) { const int j = n - 3680; return 10912 + (j < 32 ? 2 * j : 2 * (j - 32) + 1); }
        if (n < 4768) return 3072 + (n - 3744);
        return 4096 + (n - 4768);
    }
    const int h = n / 192, c = n - h * 192;
    if (c < 128) return n;
    const int j = c - 128; return h * 192 + 128 + (j < 32 ? 2 * j : 2 * (j - 32) + 1);
}
__device__ __forceinline__ void conv_item(const float* W, int Ksrc, int Nsrc, int ldsrc, bf16_t* Wt, int Kd, const float* gain, int map, int kb, int nb, LAS float* scr, int lane) {
    const int k0 = kb * 64, n0 = nb * 64;
    const int lk = lane >> 4, ln = (lane & 15) * 4;
    f32x4 v[16];
#pragma unroll
    for (int i = 0; i < 16; ++i) { const int k = k0 + 4 * i + lk, n = n0 + ln;
        const bool ok = (k < Ksrc) && (n < Nsrc);
        v[i] = ok ? *(const f32x4*)(W + (size_t)k * ldsrc + n) : (f32x4){0.f, 0.f, 0.f, 0.f};
        if (gain) { const float gg = (k < Ksrc) ? gain[k] : 0.f; v[i] = v[i] * gg; } }
#pragma unroll
    for (int i = 0; i < 16; ++i) { const int kk = 4 * i + lk;
#pragma unroll
        for (int j = 0; j < 4; ++j) scr[(ln + j) * 65 + kk] = v[i][j]; }
    LDS_WAIT(); asm volatile("" ::: "memory");
    const int c = lane & 7;
#pragma unroll
    for (int j = 0; j < 8; ++j) { const int nl = (lane >> 3) + 8 * j, n = n0 + nl;
        const LAS float* s = scr + nl * 65 + 8 * c;
        u32x4 o; o.x = cvt_pk_bf16(s[0], s[1]); o.y = cvt_pk_bf16(s[2], s[3]); o.z = cvt_pk_bf16(s[4], s[5]); o.w = cvt_pk_bf16(s[6], s[7]);
        if (n < Nsrc) *(u32x4*)(Wt + (size_t)map_col(map, n) * Kd + k0 + 8 * c) = o; }
    LDS_WAIT(); asm volatile("" ::: "memory");
}
__device__ __forceinline__ void p_prologue(const Frame& F, const Args& a) {
    LAS float* scr = (LAS float*)(F.lds + F.wave * 16640);
    const int gw = F.vcu * 8 + F.wave, NGW = F.G * 8;
    constexpr int I_IN = 32 * 171, I_UQ = 8 * 24, I_UKV = 4 * 32, I_BR = 3 * 16 * 32, I_O = 32 * 32, I_EXP = 16 * 32 * 32;
    constexpr int I_LAYER = I_IN + I_UQ + I_UKV + I_BR + I_O + 3 * I_EXP;
    for (int it = gw; it < DEPTH * I_LAYER; it += NGW) {
        const int l = it / I_LAYER; int r = it - l * I_LAYER;
        unsigned char* wl = a.ws + WS_W + (size_t)l * W_LAYER;
        if (r < I_IN) { conv_item(a.in[I_WIN] + (size_t)l * DM * IN_COLS, DM, IN_COLS, IN_COLS, (bf16_t*)(wl + WO_IN), DM, nullptr, 1, r / 171, r % 171, scr, F.lane); continue; } r -= I_IN;
        if (r < I_UQ) { conv_item(a.in[I_WUQ] + (size_t)l * QL * 1536, QL, 1536, 1536, (bf16_t*)(wl + WO_UQ), QLP, a.in[I_QNORM] + l * QL, 2, r / 24, r % 24, scr, F.lane); continue; } r -= I_UQ;
        if (r < I_UKV) { conv_item(a.in[I_WUKV] + (size_t)l * KVL * 2048, KVL, 2048, 2048, (bf16_t*)(wl + WO_UKV), KVLP, a.in[I_KVNORM] + l * KVL, 0, r / 32, r % 32, scr, F.lane); continue; } r -= I_UKV;
        if (r < I_BR) { const int br = r / 512, q = r % 512; conv_item(a.in[I_WBR] + ((size_t)l * 3 + br) * 1024 * DM, 1024, DM, DM, (bf16_t*)(wl + WO_BR) + (size_t)br * DM * 1024, 1024, nullptr, 0, q / 32, q % 32, scr, F.lane); continue; } r -= I_BR;
        if (r < I_O) { conv_item(a.in[I_WO] + (size_t)l * DM * DM, DM, DM, DM, (bf16_t*)(wl + WO_O), DM, nullptr, 0, r / 32, r % 32, scr, F.lane); continue; } r -= I_O;
        if (r < I_EXP) { const int e = r / 1024, q = r % 1024; conv_item(a.in[I_WG] + ((size_t)l * NE + e) * DM * FF, DM, FF, FF, (bf16_t*)(wl + WO_GU) + (size_t)e * 2 * FF * DM, DM, nullptr, 0, q / 32, q % 32, scr, F.lane); continue; } r -= I_EXP;
        if (r < I_EXP) { const int e = r / 1024, q = r % 1024; conv_item(a.in[I_WU] + ((size_t)l * NE + e) * DM * FF, DM, FF, FF, (bf16_t*)(wl + WO_GU) + ((size_t)e * 2 + 1) * FF * DM, DM, nullptr, 0, q / 32, q % 32, scr, F.lane); continue; } r -= I_EXP;
        { const int e = r / 1024, q = r % 1024; conv_item(a.in[I_WD] + ((size_t)l * NE + e) * FF * DM, FF, DM, DM, (bf16_t*)(wl + WO_D) + (size_t)e * DM * FF, FF, nullptr, 0, q / 32, q % 32, scr, F.lane); }
    }
    const int gt = F.vcu * 512 + F.tid, NGT = F.G * 512;
    for (int i = gt; i < DEPTH * 96 * 256; i += NGT) { const int l = i / (96 * 256), q = i % (96 * 256), rr = q >> 8, ch = q & 255;
        const int row = rr < 64 ? 10688 + rr : 10976 + (rr - 64);
        *(u32x4*)((bf16_t*)(a.ws + WS_W + (size_t)l * W_LAYER + WO_IN) + (size_t)row * DM + ch * 8) = (u32x4){0u, 0u, 0u, 0u}; }
    for (int i = gt; i < SEQ * 32; i += NGT) { const int s = i >> 5, j = i & 31;
        const float inv = 1.0f / powf(10000.0f, (float)(2 * j) / 64.0f); const float ang = (float)s * inv;
        ((float*)(a.ws + WS_ROPEC))[i] = cosf(ang); ((float*)(a.ws + WS_ROPES))[i] = sinf(ang); }
    for (int i = gt; i < 512 * 256; i += NGT) { const int r = i >> 8, j = i & 255, c = r & 255; const int m = (c * j) & 255;
        float sn, cs; sincospif((float)m * (1.0f / 128.0f), &sn, &cs);
        ((bf16_t*)(a.ws + WS_WCH))[i] = (bf16_t)f2bf((r < 256 ? cs : sn) * 0.0625f); }
    for (int i = gt; i < 4096 * 1024; i += NGT) { const int k = i >> 10, n8 = (i & 1023) * 8; float o[8];
#pragma unroll
        for (int j = 0; j < 8; ++j) { const int np = n8 + j, n = np & 4095, m = (k * n) & 4095; float sn, cs; sincospif((float)m * (1.0f / 2048.0f), &sn, &cs); o[j] = (np < 4096 ? cs : -sn) * 0.015625f; }
        u32x4 w; w.x = cvt_pk_bf16(o[0], o[1]); w.y = cvt_pk_bf16(o[2], o[3]); w.z = cvt_pk_bf16(o[4], o[5]); w.w = cvt_pk_bf16(o[6], o[7]);
        *(u32x4*)((bf16_t*)(a.ws + WS_ADFT) + (size_t)k * 8192 + n8) = w; }
}
__device__ __forceinline__ void rms_row(const float* xrow, const float* gain, bf16_t* orow, int lane) {
    const f32x4* xr = (const f32x4*)xrow + lane; f32x4 v[8]; float s = 0.f;
#pragma unroll
    for (int j = 0; j < 8; ++j) { v[j] = xr[64 * j]; s += (v[j][0] * v[j][0] + v[j][1] * v[j][1]) + (v[j][2] * v[j][2] + v[j][3] * v[j][3]); }
    const float rstd = 1.0f / sqrtf(wave_sum(s) * (1.f / DM) + RMS_EPS);
#pragma unroll
    for (int j = 0; j < 8; ++j) { const f32x4 g = ((const f32x4*)gain)[lane + 64 * j]; const f32x4 y = v[j] * rstd * g;
        u32x2 w; w.x = cvt_pk_bf16(y[0], y[1]); w.y = cvt_pk_bf16(y[2], y[3]); ((u32x2*)orow)[lane + 64 * j] = w; }
}

__device__ __forceinline__ void na_unit(const bf16_t* Q, const bf16_t* K, const bf16_t* Vt, const LAS float* rpb2, bf16_t* Y, int b, int h, int r, int jb, int lane) {
    const int qi = lane & 15, qd = lane >> 4;
    const int rs = min(max(r - 4, 0), 56);
    const int colstart = min(max(16 * jb - 8, 0), 32);
    const int qc = 16 * jb + qi, cs = min(max(qc - 8, 0), 48);
    const int tb = b * SEQ;
    const bf16_t* qp = Q + (size_t)(tb + r * 64 + qc) * 1024 + h * 64 + qd * 8;
    const bf16x8 bq0 = *(const bf16x8*)qp, bq1 = *(const bf16x8*)(qp + 32);
    f32x4 s[16];
#pragma unroll
    for (int kr = 0; kr < 8; ++kr)
#pragma unroll
        for (int kb = 0; kb < 2; ++kb) {
            const bf16_t* kp = K + (size_t)(tb + (rs + kr) * 64 + colstart + 16 * kb + qi) * 1024 + h * 64 + qd * 8;
            const bf16x8 a0 = *(const bf16x8*)kp, a1 = *(const bf16x8*)(kp + 32);
            f32x4 z = (f32x4){0.f, 0.f, 0.f, 0.f};
            z = __builtin_amdgcn_mfma_f32_16x16x32_bf16(a0, bq0, z, 0, 0, 0);
            z = __builtin_amdgcn_mfma_f32_16x16x32_bf16(a1, bq1, z, 0, 0, 0);
            s[kr * 2 + kb] = z;
        }
    float mx = -3.0e38f;
#pragma unroll
    for (int kr = 0; kr < 8; ++kr) { const LAS float* brow = rpb2 + (h * 15 + (rs + kr - r + 7)) * 31;
#pragma unroll
        for (int kb = 0; kb < 2; ++kb)
#pragma unroll
            for (int i = 0; i < 4; ++i) { const int kc = colstart + 16 * kb + 4 * qd + i; const bool valid = (kc >= cs) && (kc < cs + 16);
                const int dc = min(max(kc - qc + 15, 0), 30);
                const float v = valid ? fmaf(s[kr * 2 + kb][i], LOG2E, brow[dc]) : -1.0e30f;
                s[kr * 2 + kb][i] = v; mx = fmaxf(mx, v); } }
    mx = fmaxf(mx, __shfl_xor(mx, 16)); mx = fmaxf(mx, __shfl_xor(mx, 32));
    float sum = 0.f;
#pragma unroll
    for (int t = 0; t < 16; ++t)
#pragma unroll
        for (int i = 0; i < 4; ++i) { const float p = __builtin_amdgcn_exp2f(s[t][i] - mx); s[t][i] = p; sum += p; }
    sum += __shfl_xor(sum, 16); sum += __shfl_xor(sum, 32);
    const float rinv = 1.0f / sum;
    f32x4 o[4];
#pragma unroll
    for (int db = 0; db < 4; ++db) o[db] = (f32x4){0.f, 0.f, 0.f, 0.f};
    const bf16_t* vbase = Vt + ((size_t)(b * 16 + h) * 64 + qi) * SEQ + colstart + 4 * qd;
#pragma unroll
    for (int kr = 0; kr < 8; ++kr) {
        u32x4 pw; pw.x = cvt_pk_bf16(s[kr * 2][0], s[kr * 2][1]); pw.y = cvt_pk_bf16(s[kr * 2][2], s[kr * 2][3]); pw.z = cvt_pk_bf16(s[kr * 2 + 1][0], s[kr * 2 + 1][1]); pw.w = cvt_pk_bf16(s[kr * 2 + 1][2], s[kr * 2 + 1][3]);
        const bf16x8 pf = *reinterpret_cast<const bf16x8*>(&pw);
#pragma unroll
        for (int db = 0; db < 4; ++db) { const bf16_t* vp = vbase + (size_t)(16 * db) * SEQ + (rs + kr) * 64;
            const u32x2 lo = *(const u32x2*)vp, hi = *(const u32x2*)(vp + 16);
            u32x4 vw; vw.x = lo.x; vw.y = lo.y; vw.z = hi.x; vw.w = hi.y;
            o[db] = __builtin_amdgcn_mfma_f32_16x16x32_bf16(*reinterpret_cast<const bf16x8*>(&vw), pf, o[db], 0, 0, 0); } }
    bf16_t* yp = Y + (size_t)(tb + r * 64 + qc) * 1024 + h * 64 + 4 * qd;
#pragma unroll
    for (int db = 0; db < 4; ++db) { u32x2 w; w.x = cvt_pk_bf16(o[db][0] * rinv, o[db][1] * rinv); w.y = cvt_pk_bf16(o[db][2] * rinv, o[db][3] * rinv); *(u32x2*)(yp + 16 * db) = w; }
}
__device__ __forceinline__ void na_phase(const Frame& F, const float* rpb, const bf16_t* Q, const bf16_t* K, const bf16_t* Vt, bf16_t* Y) {
    LAS float* tab = (LAS float*)F.lds;
    for (int i = F.tid; i < 16 * 15 * 31; i += 512) tab[i] = rpb[i] * LOG2E;
    __syncthreads();
    for (int uidx = F.vcu; uidx < 2048; uidx += F.G) {
        const int rblk = uidx & 7, jb = (uidx >> 3) & 3, h = (uidx >> 5) & 15, b = uidx >> 9;
        na_unit(Q, K, Vt, tab, Y, b, h, rblk * 8 + F.wave, jb, F.lane);
    }
    __syncthreads();
}

namespace mla {
constexpr int D = 128, NW = 8, QBLK = 32, KVBLK = 64;
constexpr float SCALE = 0.07216878364870322f;
constexpr float THR = 8.f;
constexpr int SDEPTH = 1;
constexpr int LDQ = 1536, LDK = 2048, LDP = 64;
constexpr int SHM_V = KVBLK * D * 2, SHM_K = KVBLK * D * 2, SHM_P = KVBLK * 64 * 2;
constexpr int OFF_V = 0, OFF_K = 2 * SHM_V, OFF_P = OFF_K + 2 * SHM_K, OFF_WS = OFF_P + 2 * SHM_P, SHM_ATTN = OFF_WS + NW * 64 * 4;
#define KSWZ(row, colB) ((row) * 256 + ((colB) ^ (((row) & 7) << 4)))
#define PSWZ(row, colB) ((row) * 128 + ((colB) ^ ((((row) >> 1) & 7) << 4)))
#define SBAR() __builtin_amdgcn_sched_barrier(0)
__device__ __forceinline__ int crow(int r, int hi) { return (r & 3) + 8 * (r >> 2) + 4 * hi; }
__device__ __forceinline__ void partialSM(f32x16& p0, f32x16& p1, float& m_reg, float& mn, float& alpha) {
  constexpr float C = SCALE * 1.4426950408889634f;
  float pmax = p0[0];
#pragma unroll
  for (int r = 1; r < 16; ++r) pmax = fmaxf(pmax, p0[r]);
#pragma unroll
  for (int r = 0; r < 16; ++r) pmax = fmaxf(pmax, p1[r]);
  { auto rr = __builtin_amdgcn_permlane32_swap(__float_as_uint(pmax), __float_as_uint(pmax), false, false);
    pmax = fmaxf(__uint_as_float(rr[0]), __uint_as_float(rr[1])); }
  if (__builtin_expect(__all(pmax - m_reg <= THR / SCALE), 1)) { mn = m_reg; alpha = 1.f; }
  else { mn = fmaxf(m_reg, pmax); alpha = __builtin_amdgcn_exp2f((m_reg - mn) * C); m_reg = mn; }
  float mnC = -mn * C;
#pragma unroll
  for (int r = 0; r < 16; ++r) p0[r] = fmaf(p0[r], C, mnC);
#pragma unroll
  for (int r = 0; r < 16; ++r) p1[r] = fmaf(p1[r], C, mnC);
#pragma unroll
  for (int r = 0; r < 16; ++r) p0[r] = __builtin_amdgcn_exp2f(p0[r]);
}
__device__ __forceinline__ void finishSM(f32x16& p0, f32x16& p1, float alpha, float& l_reg, bf16x8& pa0, bf16x8& pa1, bf16x8& pa2, bf16x8& pa3) {
#pragma unroll
  for (int r = 0; r < 16; ++r) p1[r] = __builtin_amdgcn_exp2f(p1[r]);
  float ps = 0;
#pragma unroll
  for (int r = 0; r < 16; ++r) ps += p0[r];
#pragma unroll
  for (int r = 0; r < 16; ++r) ps += p1[r];
  { auto rr = __builtin_amdgcn_permlane32_swap(__float_as_uint(ps), __float_as_uint(ps), false, false);
    ps = __uint_as_float(rr[0]) + __uint_as_float(rr[1]); }
  l_reg = l_reg * alpha + ps;
#define PK4(P, BASE, OUT) do { unsigned a0 = cvt_pk_bf16(P[BASE + 0], P[BASE + 1]), a1 = cvt_pk_bf16(P[BASE + 2], P[BASE + 3]);   \
    unsigned b0 = cvt_pk_bf16(P[BASE + 4], P[BASE + 5]), b1 = cvt_pk_bf16(P[BASE + 6], P[BASE + 7]);                              \
    auto r0 = __builtin_amdgcn_permlane32_swap(a0, b0, false, false); auto r1 = __builtin_amdgcn_permlane32_swap(a1, b1, false, false); \
    u32x4 w = {r0[0], r1[0], r0[1], r1[1]}; OUT = *reinterpret_cast<bf16x8*>(&w); } while (0)
  PK4(p0, 0, pa0); PK4(p0, 8, pa1); PK4(p1, 0, pa2); PK4(p1, 8, pa3);
#undef PK4
}
__device__ __forceinline__ void qkt(f32x16& p0, f32x16& p1, const char* Ks, const char* Ps, const bf16x8* qr, int r32, int hi) {
  p0 = f32x16{}; p1 = f32x16{};
#pragma unroll
  for (int d0 = 0; d0 < 8; ++d0) { int cb = (d0 * 16 + hi * 8) * 2;
    bf16x8 b0 = *reinterpret_cast<const bf16x8*>(Ks + KSWZ(r32, cb));
    bf16x8 b1 = *reinterpret_cast<const bf16x8*>(Ks + KSWZ(32 + r32, cb));
    p0 = __builtin_amdgcn_mfma_f32_32x32x16_bf16(b0, qr[d0], p0, 0, 0, 0);
    p1 = __builtin_amdgcn_mfma_f32_32x32x16_bf16(b1, qr[d0], p1, 0, 0, 0); }
#pragma unroll
  for (int d0 = 0; d0 < 4; ++d0) { int cb = (d0 * 16 + hi * 8) * 2;
    bf16x8 b0 = *reinterpret_cast<const bf16x8*>(Ps + PSWZ(r32, cb));
    bf16x8 b1 = *reinterpret_cast<const bf16x8*>(Ps + PSWZ(32 + r32, cb));
    p0 = __builtin_amdgcn_mfma_f32_32x32x16_bf16(b0, qr[8 + d0], p0, 0, 0, 0);
    p1 = __builtin_amdgcn_mfma_f32_32x32x16_bf16(b1, qr[8 + d0], p1, 0, 0, 0); }
}
__device__ __forceinline__ int v_st(int k, int c) { const int kk = (k & ~0xC) | ((k & 4) << 1) | ((k & 8) >> 1); return ((kk >> 3) * 4 + (c >> 5)) * 512 + ((kk & 7) * 32 + (c & 31)) * 2; }
__device__ __forceinline__ int v_rd_base(int lane) { return ((lane & 3) << 3) | (((lane >> 2) & 3) << 6) | (((lane >> 4) & 1) << 5) | (((lane >> 5) & 1) << 8); }
constexpr int v_rd_off(int d0, int ks, int half) { return d0 * 512 + ks * 4096 + half * 2048; }
template <int OFF> __device__ __forceinline__ s16x4 tr_read(int vb) {
  s16x4 r; asm volatile("ds_read_b64_tr_b16 %0, %1 offset:%2" : "=&v"(r) : "v"(vb), "i"(OFF) : "memory"); return r;
}
template <int D0> __device__ __forceinline__ void pv_one(f32x16& od, int vb, bf16x8 pa0, bf16x8 pa1, bf16x8 pa2, bf16x8 pa3) {
  const s16x4 l0 = tr_read<v_rd_off(D0, 0, 0)>(vb), h0 = tr_read<v_rd_off(D0, 0, 1)>(vb), l1 = tr_read<v_rd_off(D0, 1, 0)>(vb), h1 = tr_read<v_rd_off(D0, 1, 1)>(vb);
  const s16x4 l2 = tr_read<v_rd_off(D0, 2, 0)>(vb), h2 = tr_read<v_rd_off(D0, 2, 1)>(vb), l3 = tr_read<v_rd_off(D0, 3, 0)>(vb), h3 = tr_read<v_rd_off(D0, 3, 1)>(vb);
  asm volatile("s_waitcnt lgkmcnt(0)" ::: "memory"); SBAR();
#define PK(L, H) (bf16x8){L[0], L[1], L[2], L[3], H[0], H[1], H[2], H[3]}
  od = __builtin_amdgcn_mfma_f32_32x32x16_bf16(pa0, PK(l0, h0), od, 0, 0, 0);
  od = __builtin_amdgcn_mfma_f32_32x32x16_bf16(pa1, PK(l1, h1), od, 0, 0, 0);
  od = __builtin_amdgcn_mfma_f32_32x32x16_bf16(pa2, PK(l2, h2), od, 0, 0, 0);
  od = __builtin_amdgcn_mfma_f32_32x32x16_bf16(pa3, PK(l3, h3), od, 0, 0, 0);
#undef PK
}
__device__ __forceinline__ void pv_d0(f32x16* o, int vb, bf16x8 pa0, bf16x8 pa1, bf16x8 pa2, bf16x8 pa3) {
  pv_one<0>(o[0], vb, pa0, pa1, pa2, pa3); pv_one<1>(o[1], vb, pa0, pa1, pa2, pa3); pv_one<2>(o[2], vb, pa0, pa1, pa2, pa3); pv_one<3>(o[3], vb, pa0, pa1, pa2, pa3);
}
__device__ __forceinline__ void attn_body(const bf16_t* __restrict__ Qb, const bf16_t* __restrict__ Kh, const bf16_t* __restrict__ Vh, const bf16_t* __restrict__ Ph,
                                          bf16_t* __restrict__ Ob, int seq, char* lds) {
  int tid_ = threadIdx.x; asm volatile("" : "+v"(tid_));
  const int tid = tid_, wid = tid >> 6, lane = tid & 63, r32 = lane & 31, hi = lane >> 5;
  char* V_lds = lds + OFF_V; char* K_lds = lds + OFF_K; char* P_lds = lds + OFF_P;
  float* ws = (float*)(lds + OFF_WS) + wid * 64; float* li_l = ws; float* al_l = ws + 32;
  float m_reg = -1e30f, l_reg = 0; f32x16 o[4] = {}; bf16x8 qr[12];
  const bf16_t* Qw = Qb + (long)(wid * QBLK + r32) * LDQ + hi * 8;
#pragma unroll
  for (int d0 = 0; d0 < 12; ++d0) qr[d0] = *reinterpret_cast<const bf16x8*>(Qw + d0 * 16);
  const int sr = tid >> 4, sc = (tid & 15) * 8, vst0 = v_st(sr, sc), vst1 = v_st(32 + sr, sc);
  const int pr = tid >> 3, pc = (tid & 7) * 8;
  const int vb0 = (int)(uintptr_t)V_lds + v_rd_base(lane);
  struct { bf16x8 vs0, vs1, ks0, ks1, ps; } sr_[SDEPTH];
#define SLOAD(i, k0) do { sr_[i].vs0 = *reinterpret_cast<const bf16x8*>(&Vh[(long)((k0) + sr) * LDK + sc]); sr_[i].vs1 = *reinterpret_cast<const bf16x8*>(&Vh[(long)((k0) + 32 + sr) * LDK + sc]); \
    sr_[i].ks0 = *reinterpret_cast<const bf16x8*>(&Kh[(long)((k0) + sr) * LDK + sc]); sr_[i].ks1 = *reinterpret_cast<const bf16x8*>(&Kh[(long)((k0) + 32 + sr) * LDK + sc]); \
    sr_[i].ps = *reinterpret_cast<const bf16x8*>(&Ph[(long)((k0) + pr) * LDP + pc]); } while (0)
#define SWRITE(b, i) do { *(bf16x8*)(V_lds + (b) * SHM_V + vst0) = sr_[i].vs0; *(bf16x8*)(V_lds + (b) * SHM_V + vst1) = sr_[i].vs1; int kc = sc * 2; \
    *(bf16x8*)(K_lds + (b) * SHM_K + KSWZ(sr, kc)) = sr_[i].ks0; *(bf16x8*)(K_lds + (b) * SHM_K + KSWZ(32 + sr, kc)) = sr_[i].ks1; \
    *(bf16x8*)(P_lds + (b) * SHM_P + PSWZ(pr, pc * 2)) = sr_[i].ps; } while (0)
#define SWAIT() do { if constexpr (SDEPTH == 2) asm volatile("s_waitcnt vmcnt(5)" ::: "memory"); else asm volatile("s_waitcnt vmcnt(0)" ::: "memory"); } while (0)
#define RESC(a) do { if (__any((a) < 1.f)) { if (hi == 0) al_l[r32] = (a); asm volatile("s_waitcnt lgkmcnt(0)" ::: "memory"); \
    _Pragma("unroll") for (int d = 0; d < 4; ++d) _Pragma("unroll") for (int r = 0; r < 16; ++r) o[d][r] *= al_l[crow(r, hi)]; } } while (0)
  f32x16 pA0, pA1, pB0, pB1; float mnA, mnB, alA, alB; bf16x8 pa0, pa1, pa2, pa3; const int NT = seq / KVBLK;
  constexpr int SE = 0, SO = SDEPTH - 1;
  SLOAD(SE, 0); asm volatile("s_waitcnt vmcnt(0)" ::: "memory"); SWRITE(0, SE); __syncthreads();
  qkt(pA0, pA1, K_lds, P_lds, qr, r32, hi); partialSM(pA0, pA1, m_reg, mnA, alA);
  SLOAD(SO, KVBLK); if constexpr (SDEPTH == 2) { if (2 < NT) SLOAD(SE, 2 * KVBLK); }
  SWAIT(); SWRITE(1, SO); __syncthreads();
  for (int j = 1; j + 1 < NT; j += 2) {
    SBAR(); qkt(pB0, pB1, K_lds + SHM_K, P_lds + SHM_P, qr, r32, hi);
    finishSM(pA0, pA1, alA, l_reg, pa0, pa1, pa2, pa3); SBAR();
    SLOAD(SO, (j + SDEPTH) * KVBLK); SBAR();
    pv_d0(o, vb0, pa0, pa1, pa2, pa3); partialSM(pB0, pB1, m_reg, mnB, alB);
    __syncthreads(); SWAIT(); SWRITE(0, SE);
    RESC(alB); __syncthreads();
    SBAR(); qkt(pA0, pA1, K_lds, P_lds, qr, r32, hi);
    finishSM(pB0, pB1, alB, l_reg, pa0, pa1, pa2, pa3); SBAR();
    if (SDEPTH == 1 || j + 3 < NT) SLOAD(SE, (j + 1 + SDEPTH) * KVBLK); SBAR();
    pv_d0(o, vb0 + (int)SHM_V, pa0, pa1, pa2, pa3); partialSM(pA0, pA1, m_reg, mnA, alA);
    __syncthreads(); SWAIT(); SWRITE(1, SO);
    RESC(alA); __syncthreads();
  }
  SBAR(); qkt(pB0, pB1, K_lds + SHM_K, P_lds + SHM_P, qr, r32, hi);
  finishSM(pA0, pA1, alA, l_reg, pa0, pa1, pa2, pa3); SBAR();
  pv_d0(o, vb0, pa0, pa1, pa2, pa3); partialSM(pB0, pB1, m_reg, mnB, alB);
  __syncthreads(); RESC(alB);
  finishSM(pB0, pB1, alB, l_reg, pa0, pa1, pa2, pa3); SBAR();
  pv_d0(o, vb0 + (int)SHM_V, pa0, pa1, pa2, pa3);
  if (hi == 0) li_l[r32] = l_reg; asm volatile("s_waitcnt lgkmcnt(0)" ::: "memory");
  float rli[16];
#pragma unroll
  for (int r = 0; r < 16; ++r) rli[r] = __builtin_amdgcn_rcpf(li_l[crow(r, hi)]);
  bf16_t* Ow = Ob + (long)(wid * QBLK) * 1024;
#pragma unroll
  for (int r = 0; r < 16; ++r) { int orow = crow(r, hi);
#pragma unroll
    for (int d0 = 0; d0 < 4; ++d0) Ow[(long)orow * 1024 + d0 * 32 + r32] = (bf16_t)f2bf(o[d0][r] * rli[r]); }
  __syncthreads();
#undef SLOAD
#undef SWRITE
#undef SWAIT
#undef RESC
}
}

__device__ __forceinline__ void router_phase(const Frame& F, const float* h, const float* gain, const float* wr, bf16_t* xn, float* aff) {
    LAS float* wt = (LAS float*)F.lds;
    for (int i = F.tid; i < DM * NE; i += 512) { const int k = i >> 4, e = i & 15; wt[e * DM + k] = wr[i]; }
    __syncthreads();
    const int gw = F.vcu * 8 + F.wave, NGW = F.G * 8;
    for (int t = gw; t < T; t += NGW) {
        const f32x4* xr = (const f32x4*)(h + (size_t)t * DM) + F.lane; f32x4 v[8]; float s = 0.f;
#pragma unroll
        for (int j = 0; j < 8; ++j) { v[j] = xr[64 * j]; s += (v[j][0] * v[j][0] + v[j][1] * v[j][1]) + (v[j][2] * v[j][2] + v[j][3] * v[j][3]); }
        const float rstd = 1.0f / sqrtf(wave_sum(s) * (1.f / DM) + RMS_EPS);
#pragma unroll
        for (int j = 0; j < 8; ++j) { const f32x4 g = ((const f32x4*)gain)[F.lane + 64 * j]; v[j] = v[j] * rstd * g;
            u32x2 w; w.x = cvt_pk_bf16(v[j][0], v[j][1]); w.y = cvt_pk_bf16(v[j][2], v[j][3]); ((u32x2*)(xn + (size_t)t * DM))[F.lane + 64 * j] = w; }
        float lg[16];
#pragma unroll
        for (int e = 0; e < 16; ++e) { float a = 0.f;
#pragma unroll
            for (int j = 0; j < 8; ++j) { const f32x4 w = *(const LAS f32x4*)(wt + e * DM + 4 * F.lane + 256 * j); a += (v[j][0] * w[0] + v[j][1] * w[1]) + (v[j][2] * w[2] + v[j][3] * w[3]); }
            lg[e] = wave_sum(a); }
        float mx = lg[0];
#pragma unroll
        for (int e = 1; e < 16; ++e) mx = fmaxf(mx, lg[e]);
        float sum = 0.f;
#pragma unroll
        for (int e = 0; e < 16; ++e) { lg[e] = __expf(lg[e] - mx); sum += lg[e]; }
        const float rs = 1.0f / sum; float mine = 0.f;
#pragma unroll
        for (int e = 0; e < 16; ++e) mine = (F.lane == e) ? lg[e] * rs : mine;
        if (F.lane < 16) aff[((size_t)(t >> 12) * NE + F.lane) * SEQ + (t & 4095)] = mine;
    }
    __syncthreads();
}
__device__ __forceinline__ void topk_unit(const Frame& F, const float* aff, int b, int e, int* mrows, float* mgate, int* slot_of) {
    LAS int* hist = (LAS int*)F.lds; LAS int* misc = hist + 256; LAS int* wtot = hist + 272;
    const float* ap = aff + ((size_t)b * NE + e) * SEQ + F.tid * 8;
    const f32x4 x0 = *(const f32x4*)ap, x1 = *(const f32x4*)(ap + 4);
    unsigned uu[8];
#pragma unroll
    for (int i = 0; i < 4; ++i) { uu[i] = __float_as_uint(x0[i]); uu[4 + i] = __float_as_uint(x1[i]); }
    unsigned prefix = 0; int kth = CAP;
#pragma unroll 1
    for (int pass = 0; pass < 4; ++pass) {
        const int shift = 24 - 8 * pass;
        if (F.tid < 256) hist[F.tid] = 0;
        __syncthreads();
#pragma unroll
        for (int i = 0; i < 8; ++i) { const bool in = (pass == 0) || ((uu[i] >> (shift + 8)) == (prefix >> (shift + 8)));
            if (in) atomicAdd((int*)&hist[(uu[i] >> shift) & 255], 1); }
        __syncthreads();
        if (F.wave == 0) {
            const int c0 = hist[4 * F.lane], c1 = hist[4 * F.lane + 1], c2 = hist[4 * F.lane + 2], c3 = hist[4 * F.lane + 3];
            const int tot = c0 + c1 + c2 + c3; int x = tot;
#pragma unroll
            for (int o = 1; o < 64; o <<= 1) { const int y = __shfl_down(x, o); if (F.lane + o < 64) x += y; }
            const int above = x - tot;
            if (above < kth && kth <= above + tot) {
                int a = above, bin, nk;
                if (kth <= a + c3) { bin = 3; nk = kth - a; }
                else { a += c3; if (kth <= a + c2) { bin = 2; nk = kth - a; }
                else { a += c2; if (kth <= a + c1) { bin = 1; nk = kth - a; }
                else { a += c1; bin = 0; nk = kth - a; } } }
                misc[0] = 4 * F.lane + bin; misc[1] = nk;
            }
        }
        __syncthreads();
        prefix |= ((unsigned)misc[0]) << shift; kth = misc[1];
        __syncthreads();
    }
    int cg = 0, ce = 0;
#pragma unroll
    for (int i = 0; i < 8; ++i) { cg += (uu[i] > prefix) ? 1 : 0; ce += (uu[i] == prefix) ? 1 : 0; }
    int pk = cg | (ce << 16), inc = pk;
#pragma unroll
    for (int o = 1; o < 64; o <<= 1) { const int y = __shfl_up(inc, o); if (F.lane >= o) inc += y; }
    if (F.lane == 63) wtot[F.wave] = inc;
    __syncthreads();
    int base = 0;
#pragma unroll
    for (int w = 0; w < 8; ++w) base += (w < F.wave) ? wtot[w] : 0;
    int excl = base + inc - pk; int gb = excl & 0xffff, eb = excl >> 16;
#pragma unroll
    for (int i = 0; i < 8; ++i) { const int s = F.tid * 8 + i; const bool g = uu[i] > prefix, q = uu[i] == prefix;
        const bool sel = g || (q && eb < kth);
        const int slot = gb + min(eb, kth);
        if (sel) { mrows[e * ROWS_E + b * CAP + slot] = b * SEQ + s; mgate[e * ROWS_E + b * CAP + slot] = __uint_as_float(uu[i]); }
        slot_of[(size_t)(b * SEQ + s) * NE + e] = sel ? (b * CAP + slot) : -1;
        gb += g ? 1 : 0; eb += q ? 1 : 0; }
    __syncthreads();
}
__device__ __forceinline__ void combine_phase(const Frame& F, float* h, const bf16_t* ye, const int* slot_of, const float* gain, bf16_t* xn_next, float* out_final) {
    const int gw = F.vcu * 8 + F.wave, NGW = F.G * 8;
    for (int t = gw; t < T; t += NGW) {
        f32x4* hr = (f32x4*)(h + (size_t)t * DM) + F.lane; f32x4 v[8];
#pragma unroll
        for (int j = 0; j < 8; ++j) v[j] = hr[64 * j];
        const int so = slot_of[(size_t)t * NE + (F.lane & 15)];
        unsigned long long mask = __ballot(F.lane < 16 && so >= 0);
        while (mask) { const int e = __builtin_amdgcn_readfirstlane((int)__builtin_ctzll(mask)); mask &= mask - 1;
            const int slot = __builtin_amdgcn_readlane(so, e);
            const u32x2* yr = (const u32x2*)(ye + ((size_t)e * ROWS_E + slot) * DM) + F.lane;
#pragma unroll
            for (int j = 0; j < 8; ++j) { const u32x2 w = yr[64 * j];
                v[j][0] += __uint_as_float(w.x << 16); v[j][1] += __uint_as_float(w.x & 0xffff0000u); v[j][2] += __uint_as_float(w.y << 16); v[j][3] += __uint_as_float(w.y & 0xffff0000u); } }
        float s = 0.f;
#pragma unroll
        for (int j = 0; j < 8; ++j) s += (v[j][0] * v[j][0] + v[j][1] * v[j][1]) + (v[j][2] * v[j][2] + v[j][3] * v[j][3]);
        const float rstd = 1.0f / sqrtf(wave_sum(s) * (1.f / DM) + RMS_EPS);
        if (xn_next) {
#pragma unroll
            for (int j = 0; j < 8; ++j) { hr[64 * j] = v[j]; const f32x4 g = ((const f32x4*)gain)[F.lane + 64 * j]; const f32x4 y = v[j] * rstd * g;
                u32x2 w; w.x = cvt_pk_bf16(y[0], y[1]); w.y = cvt_pk_bf16(y[2], y[3]); ((u32x2*)(xn_next + (size_t)t * DM))[F.lane + 64 * j] = w; }
        } else {
#pragma unroll
            for (int j = 0; j < 8; ++j) { if (MK_DEBUG) hr[64 * j] = v[j]; const f32x4 g = ((const f32x4*)gain)[F.lane + 64 * j]; ((f32x4*)(out_final + (size_t)t * DM))[F.lane + 64 * j] = v[j] * rstd * g; }
        }
    }
}

#ifndef PHMASK
#define PHMASK 0xFFFFF
#endif
#define EN(b) if constexpr ((PHMASK >> (b)) & 1)
constexpr int N_PHASES = 1 + 10 * DEPTH;
__device__ __forceinline__ bool in_range(int lo, int hi, int k) { asm volatile("" : "+s"(lo), "+s"(hi)); return lo <= k && k < hi; }
__global__ void __launch_bounds__(512, 2) fwd(Args a) {
    extern __shared__ __attribute__((aligned(16))) unsigned char lds[];
    Frame F;
    F.lds = (LAS unsigned char*)lds;
    F.tid = threadIdx.x; F.lane = F.tid & 63; F.wave = __builtin_amdgcn_readfirstlane(F.tid >> 6);
    F.G = gridDim.x; { const int bx = blockIdx.x; F.vcu = (F.G % 8 == 0) ? (bx % 8) * (F.G / 8) + bx / 8 : bx; }
    volatile LAS unsigned* MISC = (volatile LAS unsigned*)(F.lds + MISC_OFF);
    if (F.tid < 64) MISC[F.tid] = 0u;
    __syncthreads();
    const int lo = a.ph_lo, hi = a.ph_hi;
    XcdBarrier bar; bar.bar = (unsigned*)(a.ws + WS_CTL); bar.x = 0; bar.st = MISC + 8;
    if (hi - lo > 1) bar = xcd_barrier_post((unsigned*)(a.ws + WS_CTL), MISC + 8);
#define IN(k) in_range(lo, hi, (k))
#define SEAM(k) do { if (IN(k) && IN((k) + 1)) xcd_barrier<false>(bar); } while (0)
#define WSO() int cb = blockIdx.x, G = gridDim.x; asm volatile("" : "+s"(cb), "+s"(G)); F.G = G; F.vcu = (G % 8 == 0) ? (cb % 8) * (G / 8) + cb / 8 : cb; { int t_ = threadIdx.x; asm volatile("" : "+v"(t_)); F.tid = t_; F.lane = t_ & 63; F.wave = __builtin_amdgcn_readfirstlane(t_ >> 6); } size_t z_ = 0; asm volatile("" : "+s"(z_)); unsigned char* ws = a.ws + z_; bf16_t* XN = (bf16_t*)(ws + WS_XN); float* H = (float*)(ws + WS_H); const unsigned char* wl = ws + WS_W + (size_t)l * W_LAYER; (void)XN; (void)H; (void)wl; (void)cb

    if (IN(0)) EN(0) {
        const int l = 0; WSO();
        p_prologue(F, a);
        const int gw = F.vcu * 8 + F.wave, NGW = F.G * 8;
        for (int t = gw; t < T; t += NGW) rms_row(a.in[I_X] + (size_t)t * DM, a.in[I_NMIX], XN + (size_t)t * DM, F.lane);
    }
    if (hi - lo > 1) xcd_barrier<true>(bar);
#pragma unroll 1
    for (int l = 0; l < DEPTH; ++l) {
        const int P = 1 + 10 * l;
        if (IN(P + 0)) EN(1) {
            WSO();
            const Shape g{DM, DM, DM, 128u * DM * 2u};
            const SchedGrid S{(const char*)XN, (const char*)(wl + WO_IN), (size_t)256 * DM * 2, (size_t)256 * DM * 2, 64, NIN / 256, G, cb};
            const EpiInProj E{(bf16_t*)(ws + WS_QNA), (bf16_t*)(ws + WS_KNA), (bf16_t*)(ws + WS_VT), (bf16_t*)(ws + WS_UF), (bf16_t*)(ws + WS_GATES), (bf16_t*)(ws + WS_CQ), (bf16_t*)(ws + WS_CKV), (bf16_t*)(ws + WS_KPE),
                              a.in[I_BGATE] + (size_t)l * 6144, (const float*)(ws + WS_ROPEC), (const float*)(ws + WS_ROPES), (float*)(ws + WS_SSQQ), (float*)(ws + WS_SSQKV)};
            pg8::gemm_phase<EpiInProj, SchedGrid, false>(F.lds, g, S, E);
        }
        SEAM(P + 0);
        if (IN(P + 1)) {
            EN(2) { WSO(); const Shape g{256, 256, 1024, 128u * 1024u * 2u}; const SchedF1 S{(const char*)(ws + WS_WCH), (const char*)(ws + WS_UF), G, F.vcu}; const EpiF1 E{(bf16_t*)(ws + WS_ZT)};
              pg8::gemm_phase<EpiF1, SchedF1, false>(F.lds, g, S, E); }
            EN(3) { WSO(); const Shape g{QLP, QLP, QLP, 128u * QLP * 2u}; const SchedGrid S{(const char*)(ws + WS_CQ), (const char*)(wl + WO_UQ), (size_t)256 * QLP * 2, (size_t)256 * QLP * 2, 64, 6, G, cb};
              const EpiQup E{(bf16_t*)(ws + WS_QMLA), (const float*)(ws + WS_SSQQ), (const float*)(ws + WS_ROPEC), (const float*)(ws + WS_ROPES)};
              pg8::gemm_phase<EpiQup, SchedGrid, false>(F.lds, g, S, E); }
            EN(4) { WSO(); const Shape g{KVLP, KVLP, KVLP, 128u * KVLP * 2u}; const SchedGrid S{(const char*)(ws + WS_CKV), (const char*)(wl + WO_UKV), (size_t)256 * KVLP * 2, (size_t)256 * KVLP * 2, 64, 8, G, cb};
              const EpiKVup E{(bf16_t*)(ws + WS_KVMLA), (const float*)(ws + WS_SSQKV)};
              pg8::gemm_phase<EpiKVup, SchedGrid, false>(F.lds, g, S, E); }
            EN(5) { WSO(); na_phase(F, a.in[I_RPB] + (size_t)l * 16 * 15 * 31, (const bf16_t*)(ws + WS_QNA), (const bf16_t*)(ws + WS_KNA), (const bf16_t*)(ws + WS_VT), (bf16_t*)(ws + WS_YNA)); }
        }
        SEAM(P + 1);
        if (IN(P + 2)) {
            EN(6) { WSO(); const Shape g{8192, 8192, 8192, 128u * 8192u * 2u}; const SchedDft S{(const char*)(ws + WS_ADFT), (const char*)(ws + WS_ZT), F.vcu}; const EpiBf16 E{(bf16_t*)(ws + WS_YF), 1024};
              pg8::gemm_phase<EpiBf16, SchedDft, false>(F.lds, g, S, E); }
            EN(7) for (int uidx = F.vcu; uidx < 512; uidx += F.G) {
                WSO();
                const int qb = uidx & 15, h = (uidx >> 4) & 7, b = uidx >> 7;
                const bf16_t* kv = (const bf16_t*)(ws + WS_KVMLA) + (size_t)b * SEQ * 2048 + h * 256;
                mla::attn_body((const bf16_t*)(ws + WS_QMLA) + ((size_t)b * SEQ + qb * 256) * 1536 + h * 192, kv, kv + 128, (const bf16_t*)(ws + WS_KPE) + (size_t)b * SEQ * 64,
                               (bf16_t*)(ws + WS_YMLA) + ((size_t)b * SEQ + qb * 256) * 1024 + h * 128, SEQ, (char*)lds);
            }
        }
        SEAM(P + 2);
        if (IN(P + 3)) EN(8) {
            WSO();
            const Shape g{1024, 1024, 1024, 128u * 1024u * 2u};
            const SchedBranch S{{(const char*)(ws + WS_YNA), (const char*)(ws + WS_YMLA), (const char*)(ws + WS_YF)}, (const char*)(wl + WO_BR), G, cb};
            const EpiBranch E{(const bf16_t*)(ws + WS_GATES), (float*)(ws + WS_MPART), (bf16_t*)(ws + WS_MERGED)};
            pg8::gemm_phase<EpiBranch, SchedBranch, false>(F.lds, g, S, E);
        }
        SEAM(P + 3);
        if (IN(P + 4)) EN(9) {
            WSO();
            const Shape g{DM, DM, DM, 128u * DM * 2u};
            const SchedGrid S{(const char*)(ws + WS_MERGED), (const char*)(wl + WO_O), (size_t)256 * DM * 2, (size_t)256 * DM * 2, 64, 8, G, cb};
            const EpiResid E{l == 0 ? a.in[I_X] : (const float*)H, H};
            pg8::gemm_phase<EpiResid, SchedGrid, false>(F.lds, g, S, E);
        }
        SEAM(P + 4);
        if (IN(P + 5)) EN(10) { WSO(); router_phase(F, H, a.in[I_NMOE] + (size_t)l * DM, a.in[I_WROUTER] + (size_t)l * DM * NE, XN, (float*)(ws + WS_AFF)); }
        SEAM(P + 5);
        if (IN(P + 6)) EN(11) { WSO(); if (F.vcu < NB * NE) topk_unit(F, (const float*)(ws + WS_AFF), F.vcu >> 4, F.vcu & 15, (int*)(ws + WS_MROWS), (float*)(ws + WS_MGATE), (int*)(ws + WS_SLOT)); }
        SEAM(P + 6);
        if (IN(P + 7)) EN(12) {
            WSO();
            const Shape g{DM, DM, DM, (unsigned)(FF * DM * 2)};
            const SchedMoe1 S{(const char*)XN, (const int*)(ws + WS_MROWS), (const char*)(wl + WO_GU), G, F.vcu};
            const EpiSwiglu E{(bf16_t*)(ws + WS_HMOE)};
            pg8::gemm_phase<EpiSwiglu, SchedMoe1, true>(F.lds, g, S, E);
        }
        SEAM(P + 7);
        if (IN(P + 8)) EN(13) {
            WSO();
            const Shape g{FF, FF, FF, 128u * FF * 2u};
            const SchedMoe2 S{(const char*)(ws + WS_HMOE), (const char*)(wl + WO_D), G, F.vcu};
            const EpiDown E{(bf16_t*)(ws + WS_YE), (const float*)(ws + WS_MGATE)};
            pg8::gemm_phase<EpiDown, SchedMoe2, false>(F.lds, g, S, E);
        }
        SEAM(P + 8);
        if (IN(P + 9)) EN(14) {
            WSO();
            if (l + 1 < DEPTH) combine_phase(F, H, (const bf16_t*)(ws + WS_YE), (const int*)(ws + WS_SLOT), a.in[I_NMIX] + (size_t)(l + 1) * DM, XN, nullptr);
            else combine_phase(F, H, (const bf16_t*)(ws + WS_YE), (const int*)(ws + WS_SLOT), a.in[I_NFINAL], nullptr, a.out);
        }
        SEAM(P + 9);
    }
#undef IN
#undef SEAM
}


#if MK_DEBUG
__device__ __forceinline__ unsigned hsh(unsigned x) { x ^= x >> 16; x *= 0x7feb352dU; x ^= x >> 15; x *= 0x846ca68bU; x ^= x >> 16; return x; }
__device__ __forceinline__ float bfr(float f) { return __uint_as_float(f2bf(f) << 16); }
__device__ __forceinline__ void rep(unsigned char* ws, int id, double got, double ex, double rel, double ab) { const double err = fabs(got - ex); if (!(err <= rel * fabs(ex) + ab)) ((int*)(ws + WS_DBG))[id] = 1; }
#define WSB(off) ((const bf16_t*)(ws + (off)))
#define WSF(off) ((const float*)(ws + (off)))
__device__ int inproj_dst2src(int n) {
    if (n < 3072) return n; if (n < 4096) return 3744 + (n - 3072); if (n < 10240) return 4768 + (n - 4096); if (n < 10688) return 3072 + (n - 10240); if (n < 10752) return -1;
    if (n < 10912) return 3520 + (n - 10752); if (n < 10976) { const int i = n - 10912; return 3680 + (i >> 1) + 32 * (i & 1); } return -1; }
__global__ void chk_prologue(Args a) {
    unsigned char* ws = a.ws; const unsigned i = blockIdx.x * blockDim.x + threadIdx.x; const unsigned r = hsh(i * 7 + 1), r2 = hsh(r + 12345);
    for (int l = 0; l < DEPTH; ++l) { const unsigned char* wl = ws + WS_W + (size_t)l * W_LAYER;
        { const int n = r % NIN, k = r2 % DM, sc = inproj_dst2src(n); const float ex = sc < 0 ? 0.f : bfr(a.in[I_WIN][((size_t)l * DM + k) * IN_COLS + sc]); rep(ws, 1, bf2f(((const bf16_t*)(wl + WO_IN))[(size_t)n * DM + k]), ex, 0, 1e-12); }
        { const int n = r % 1536, k = r2 % QLP, h = n / 192, c = n % 192; int sc = n; if (c >= 128) { const int ii = c - 128; sc = h * 192 + 128 + (ii >> 1) + 32 * (ii & 1); }
          const float ex = k < QL ? bfr(a.in[I_WUQ][((size_t)l * QL + k) * 1536 + sc] * a.in[I_QNORM][l * QL + k]) : 0.f; rep(ws, 2, bf2f(((const bf16_t*)(wl + WO_UQ))[(size_t)n * QLP + k]), ex, 0, 1e-12); }
        { const int n = r % 2048, k = r2 % KVLP; const float ex = k < KVL ? bfr(a.in[I_WUKV][((size_t)l * KVL + k) * 2048 + n] * a.in[I_KVNORM][l * KVL + k]) : 0.f; rep(ws, 3, bf2f(((const bf16_t*)(wl + WO_UKV))[(size_t)n * KVLP + k]), ex, 0, 1e-12); }
        { const int br = r % 3, n = (r >> 2) % DM, k = r2 % 1024; rep(ws, 4, bf2f(((const bf16_t*)(wl + WO_BR))[((size_t)br * DM + n) * 1024 + k]), bfr(a.in[I_WBR][(((size_t)l * 3 + br) * 1024 + k) * DM + n]), 0, 1e-12); }
        { const int n = r % DM, k = r2 % DM; rep(ws, 5, bf2f(((const bf16_t*)(wl + WO_O))[(size_t)n * DM + k]), bfr(a.in[I_WO][((size_t)l * DM + k) * DM + n]), 0, 1e-12); }
        { const int e = r % NE, f = (r >> 4) % FF, d = r2 % DM;
          rep(ws, 6, bf2f(((const bf16_t*)(wl + WO_GU))[(((size_t)e * 2) * FF + f) * DM + d]), bfr(a.in[I_WG][(((size_t)l * NE + e) * DM + d) * FF + f]), 0, 1e-12);
          rep(ws, 6, bf2f(((const bf16_t*)(wl + WO_GU))[(((size_t)e * 2 + 1) * FF + f) * DM + d]), bfr(a.in[I_WU][(((size_t)l * NE + e) * DM + d) * FF + f]), 0, 1e-12);
          rep(ws, 7, bf2f(((const bf16_t*)(wl + WO_D))[((size_t)e * DM + d) * FF + f]), bfr(a.in[I_WD][(((size_t)l * NE + e) * FF + f) * DM + d]), 0, 1e-12); } }
    { const int t = r % T, c = r2 % DM; double ss = 0; for (int k = 0; k < DM; ++k) { const double x = a.in[I_X][(size_t)t * DM + k]; ss += x * x; }
      const double ex = a.in[I_X][(size_t)t * DM + c] / sqrt(ss / DM + 1e-6) * a.in[I_NMIX][c]; rep(ws, 8, bf2f(WSB(WS_XN)[(size_t)t * DM + c]), ex, 0.006, 1e-3); }
    { const int sp = r % SEQ, j = r2 % 32; const float inv = 1.0f / powf(10000.0f, (float)(2 * j) / 64.0f); const float ang = (float)sp * inv;
      rep(ws, 9, WSF(WS_ROPEC)[sp * 32 + j], cos((double)ang), 0, 2e-3); rep(ws, 9, WSF(WS_ROPES)[sp * 32 + j], sin((double)ang), 0, 2e-3);
      const int k = r % 4096, n = r2 % 8192; const double ph = 2.0 * M_PI * (double)(((long)k * (n & 4095)) % 4096) / 4096.0;
      rep(ws, 9, bf2f(WSB(WS_ADFT)[(size_t)k * 8192 + n]), (n < 4096 ? cos(ph) : -sin(ph)) / 64.0, 0.006, 1e-4);
      const int rr = r % 512, jj = r2 % 256; const double p2 = 2.0 * M_PI * (double)(((rr & 255) * jj) % 256) / 256.0;
      rep(ws, 9, bf2f(WSB(WS_WCH)[rr * 256 + jj]), (rr < 256 ? cos(p2) : sin(p2)) / 16.0, 0.006, 3e-4); }
}
__device__ double inproj_dot(const Args& a, int l, int t, int col) { const bf16_t* xr = (const bf16_t*)(a.ws + WS_XN) + (size_t)t * DM; const float* w = a.in[I_WIN] + (size_t)l * DM * IN_COLS + col; double s = 0;
    for (int k = 0; k < DM; ++k) s += (double)bf2f(xr[k]) * (double)bfr(w[(size_t)k * IN_COLS]); return s; }
__global__ void chk_inproj(Args a, int l) {
    unsigned char* ws = a.ws; const unsigned i = blockIdx.x * blockDim.x + threadIdx.x; const unsigned r = hsh(i * 3 + 77 + l), r2 = hsh(r + 999);
    const int t = r % T, b = t >> 12, sp = t & 4095; const int seg = i & 7; const int B10 = l * 45 + 10;
    if (seg == 0) { const int c = r2 % 1024; rep(ws, B10 + 0, bf2f(WSB(WS_QNA)[(size_t)t * 1024 + c]), inproj_dot(a, l, t, c) * 0.125, 0.01, 0.01); }
    else if (seg == 1) { const int c = r2 % 1024; rep(ws, B10 + 1, bf2f(WSB(WS_KNA)[(size_t)t * 1024 + c]), inproj_dot(a, l, t, 1024 + c), 0.01, 0.02); }
    else if (seg == 2) { const int c = r2 % 1024; rep(ws, B10 + 2, bf2f(WSB(WS_VT)[((size_t)(b * 16 + (c >> 6)) * 64 + (c & 63)) * SEQ + sp]), inproj_dot(a, l, t, 2048 + c), 0.01, 0.02); }
    else if (seg == 3) { const int c = r2 % QLP; rep(ws, B10 + 3, bf2f(WSB(WS_CQ)[(size_t)t * QLP + c]), c < QL ? inproj_dot(a, l, t, 3072 + c) : 0.0, 0.01, c < QL ? 0.02 : 0.0); }
    else if (seg == 4) { const int c = r2 % KVLP; rep(ws, B10 + 4, bf2f(WSB(WS_CKV)[(size_t)t * KVLP + c]), c < KVL ? inproj_dot(a, l, t, 3520 + c) : 0.0, 0.01, c < KVL ? 0.02 : 0.0); }
    else if (seg == 5) { const int jj = r2 % 32; const double x1 = inproj_dot(a, l, t, 3680 + jj), x2 = inproj_dot(a, l, t, 3680 + 32 + jj);
        const float inv = 1.0f / powf(10000.0f, (float)(2 * jj) / 64.0f); const double ang = (double)((float)sp * inv), cs = cos(ang), sn = sin(ang);
        rep(ws, B10 + 5, bf2f(WSB(WS_KPE)[(size_t)t * 64 + 2 * jj]), x1 * cs - x2 * sn, 0.01, 0.03); rep(ws, B10 + 5, bf2f(WSB(WS_KPE)[(size_t)t * 64 + 2 * jj + 1]), x2 * cs + x1 * sn, 0.01, 0.03); }
    else if (seg == 6) { const int c = r2 % 1024; rep(ws, B10 + 6, bf2f(WSB(WS_UF)[(size_t)t * 1024 + c]), inproj_dot(a, l, t, 3744 + c), 0.01, 0.02); }
    else { const int c = r2 % 6144; const double z = inproj_dot(a, l, t, 4768 + c) + a.in[I_BGATE][l * 6144 + c]; rep(ws, B10 + 7, bf2f(WSB(WS_GATES)[(size_t)t * 6144 + c]), 1.0 / (1.0 + exp(-z)), 0.01, 0.01);
        double sq = 0, skv = 0; for (int k = 0; k < QL; ++k) { const double x = bf2f(WSB(WS_CQ)[(size_t)t * QLP + k]); sq += x * x; } for (int k = 0; k < KVL; ++k) { const double x = bf2f(WSB(WS_CKV)[(size_t)t * KVLP + k]); skv += x * x; }
        double pq = 0, pkv = 0; for (int k = 0; k < 8; ++k) pq += WSF(WS_SSQQ)[(size_t)t * 8 + k]; for (int k = 0; k < 4; ++k) pkv += WSF(WS_SSQKV)[(size_t)t * 4 + k];
        rep(ws, B10 + 8, pq, sq, 0.02, 1e-3); rep(ws, B10 + 8, pkv, skv, 0.02, 1e-3); }
}
__global__ void chk_mid(Args a, int l) {
    unsigned char* ws = a.ws; const unsigned i = blockIdx.x * blockDim.x + threadIdx.x; const unsigned r = hsh(i * 5 + 31 + l), r2 = hsh(r + 4242);
    const int seg = i & 3; const int B20 = l * 45 + 20; const int t = r % T, b = t >> 12, sp = t & 4095;
    if (seg == 0) {
        const int g = r2 & 3, c = (r2 >> 2) & 255, part = (r2 >> 10) & 1; double s = 0;
        for (int j = 0; j < 256; ++j) { const double ph = 2.0 * M_PI * (double)((c * j) % 256) / 256.0; s += (double)bf2f(WSB(WS_UF)[(size_t)t * 1024 + g * 256 + j]) * (part ? sin(ph) : cos(ph)); }
        rep(ws, B20 + 0, bf2f(WSB(WS_ZT)[((size_t)b * 1024 + g * 256 + c) * 8192 + part * 4096 + sp]), s / 16.0, 0.015, 0.02);
    } else if (seg == 1) {
        const int h = r2 & 7, jj = (r2 >> 3) % 96; double ss = 0; for (int k = 0; k < QL; ++k) { const double x = bf2f(WSB(WS_CQ)[(size_t)t * QLP + k]); ss += x * x; } const double rstd = 1.0 / sqrt(ss / QL + 1e-6);
        auto qd = [&](int col) { double s = 0; for (int k = 0; k < QL; ++k) s += (double)bf2f(WSB(WS_CQ)[(size_t)t * QLP + k]) * (double)bfr(a.in[I_WUQ][((size_t)l * QL + k) * 1536 + col] * a.in[I_QNORM][l * QL + k]); return s * rstd; };
        if (jj < 64) { const int c = jj * 2 + (r2 >> 20 & 1); rep(ws, B20 + 1, bf2f(WSB(WS_QMLA)[(size_t)t * 1536 + h * 192 + c]), qd(h * 192 + c), 0.015, 0.03); }
        else { const int j = jj - 64; const double x1 = qd(h * 192 + 128 + j), x2 = qd(h * 192 + 160 + j); const float inv = 1.0f / powf(10000.0f, (float)(2 * j) / 64.0f); const double ang = (double)((float)sp * inv), cs = cos(ang), sn = sin(ang);
            rep(ws, B20 + 1, bf2f(WSB(WS_QMLA)[(size_t)t * 1536 + h * 192 + 128 + 2 * j]), x1 * cs - x2 * sn, 0.015, 0.04); rep(ws, B20 + 1, bf2f(WSB(WS_QMLA)[(size_t)t * 1536 + h * 192 + 128 + 2 * j + 1]), x2 * cs + x1 * sn, 0.015, 0.04); }
    } else if (seg == 2) {
        const int n = r2 % 2048; double ss = 0; for (int k = 0; k < KVL; ++k) { const double x = bf2f(WSB(WS_CKV)[(size_t)t * KVLP + k]); ss += x * x; } const double rstd = 1.0 / sqrt(ss / KVL + 1e-6);
        double s = 0; for (int k = 0; k < KVL; ++k) s += (double)bf2f(WSB(WS_CKV)[(size_t)t * KVLP + k]) * (double)bfr(a.in[I_WUKV][((size_t)l * KVL + k) * 2048 + n] * a.in[I_KVNORM][l * KVL + k]);
        rep(ws, B20 + 2, bf2f(WSB(WS_KVMLA)[(size_t)t * 2048 + n]), s * rstd, 0.015, 0.03);
    } else {
        const int h = r2 & 15, d = (r2 >> 4) & 63, gr = sp >> 6, gc = sp & 63;
        int rs = gr - 4; rs = rs < 0 ? 0 : (rs > 56 ? 56 : rs); int cs0 = gc - 8; cs0 = cs0 < 0 ? 0 : (cs0 > 48 ? 48 : cs0);
        double mx = -1e300, sum = 0, o = 0;
        for (int pass = 0; pass < 2; ++pass)
        for (int ii = 0; ii < 8; ++ii) for (int jj = 0; jj < 16; ++jj) { const int kr = rs + ii, kc = cs0 + jj, tk = b * SEQ + kr * 64 + kc; double s = 0;
            for (int dd = 0; dd < 64; ++dd) s += (double)bf2f(WSB(WS_QNA)[(size_t)t * 1024 + h * 64 + dd]) * (double)bf2f(WSB(WS_KNA)[(size_t)tk * 1024 + h * 64 + dd]);
            int ci = kc - gc + 15; ci = ci < 0 ? 0 : (ci > 30 ? 30 : ci);
            s += (double)a.in[I_RPB][(((size_t)l * 16 + h) * 15 + (kr - gr + 7)) * 31 + ci];
            if (pass == 0) mx = s > mx ? s : mx;
            else { const double p = exp(s - mx); sum += p; o += p * (double)bf2f(WSB(WS_VT)[((size_t)(b * 16 + h) * 64 + d) * SEQ + kr * 64 + kc]); } }
        rep(ws, B20 + 3, bf2f(WSB(WS_YNA)[(size_t)t * 1024 + h * 64 + d]), o / sum, 0.02, 0.01);
    }
}
__global__ void chk_dft_mla(Args a, int l) {
    unsigned char* ws = a.ws; __shared__ double red[256]; __shared__ double red2[256];
    const unsigned r = hsh(blockIdx.x * 11 + 5 + l), r2 = hsh(r + 777); const int tid = threadIdx.x; const int B25 = l * 45 + 25;
    if (blockIdx.x < 64) {
        const int b = r & 3, k = (r >> 2) & 4095, g = (r >> 14) & 3, c = r2 & 255; double s = 0;
        for (int n = tid; n < SEQ; n += 256) { const int pk = (k * n) & 4095; const bf16_t* up = WSB(WS_UF) + ((size_t)b * SEQ + n) * 1024 + g * 256;
            for (int j = 0; j < 256; ++j) { const int ph = (pk + 16 * ((c * j) & 255)) & 4095; s += (double)bf2f(up[j]) * cospi((double)ph / 2048.0); } }
        red[tid] = s; __syncthreads(); for (int o = 128; o > 0; o >>= 1) { if (tid < o) red[tid] += red[tid + o]; __syncthreads(); }
        if (tid == 0) rep(ws, B25 + 0, bf2f(WSB(WS_YF)[((size_t)b * SEQ + k) * 1024 + g * 256 + c]), red[0] / 1024.0, 0.03, 0.03);
    } else {
        const int b = r & 3, q = (r >> 2) & 4095, h = (r >> 14) & 7, d = r2 & 127; const size_t tq = (size_t)b * SEQ + q;
        double sc[16], mx = -1e300;
        for (int kk = 0; kk < 16; ++kk) { const size_t tk = (size_t)b * SEQ + tid + 256 * kk; double s = 0;
            for (int dd = 0; dd < 128; ++dd) s += (double)bf2f(WSB(WS_QMLA)[tq * 1536 + h * 192 + dd]) * (double)bf2f(WSB(WS_KVMLA)[tk * 2048 + h * 256 + dd]);
            for (int dd = 0; dd < 64; ++dd) s += (double)bf2f(WSB(WS_QMLA)[tq * 1536 + h * 192 + 128 + dd]) * (double)bf2f(WSB(WS_KPE)[tk * 64 + dd]);
            sc[kk] = s * 0.07216878364870322; mx = sc[kk] > mx ? sc[kk] : mx; }
        red[tid] = mx; __syncthreads(); for (int o = 128; o > 0; o >>= 1) { if (tid < o) red[tid] = red[tid] > red[tid + o] ? red[tid] : red[tid + o]; __syncthreads(); }
        const double gm = red[0]; __syncthreads(); double sum = 0, o = 0;
        for (int kk = 0; kk < 16; ++kk) { const size_t tk = (size_t)b * SEQ + tid + 256 * kk; const double p = exp(sc[kk] - gm); sum += p; o += p * (double)bf2f(WSB(WS_KVMLA)[tk * 2048 + h * 256 + 128 + d]); }
        red[tid] = sum; red2[tid] = o; __syncthreads(); for (int oo = 128; oo > 0; oo >>= 1) { if (tid < oo) { red[tid] += red[tid + oo]; red2[tid] += red2[tid + oo]; } __syncthreads(); }
        if (tid == 0) rep(ws, B25 + 1, bf2f(WSB(WS_YMLA)[tq * 1024 + h * 128 + d]), red2[0] / red[0], 0.02, 0.002);
    }
}
__global__ void dbg_save_h(Args a, int which, int l) {
    unsigned char* ws = a.ws; const unsigned i = blockIdx.x * blockDim.x + threadIdx.x; const unsigned r = hsh(i * 13 + 3 + l + which * 1000), r2 = hsh(r + 555);
    const int t = r % T, c = r2 % DM; ((float*)(ws + WS_DBG + 65536))[which * 4096 + i] = (which == 0 && l == 0) ? a.in[I_X][(size_t)t * DM + c] : WSF(WS_H)[(size_t)t * DM + c];
}
__global__ void chk_merge_wo(Args a, int l, int which) {
    unsigned char* ws = a.ws; const unsigned i = blockIdx.x * blockDim.x + threadIdx.x; const int B27 = l * 45 + 27;
    if (which == 0) { const unsigned r = hsh(i * 17 + 9 + l), r2 = hsh(r + 321); const int t = r % T, n = r2 % DM; double m = 0;
        const size_t yo[3] = {WS_YNA, WS_YMLA, WS_YF};
        for (int br = 0; br < 3; ++br) { double s = 0; for (int k = 0; k < 1024; ++k) s += (double)bf2f(WSB(yo[br])[(size_t)t * 1024 + k]) * (double)bfr(a.in[I_WBR][(((size_t)l * 3 + br) * 1024 + k) * DM + n]);
            m += s * (double)bf2f(WSB(WS_GATES)[(size_t)t * 6144 + br * 2048 + n]); }
        rep(ws, B27 + 0, bf2f(WSB(WS_MERGED)[(size_t)t * DM + n]), m, 0.015, 0.01);
    } else { const unsigned r = hsh(i * 13 + 3 + l + 0 * 1000), r2 = hsh(r + 555); const int t = r % T, c = r2 % DM; double s = 0;
        for (int k = 0; k < DM; ++k) s += (double)bf2f(WSB(WS_MERGED)[(size_t)t * DM + k]) * (double)bfr(a.in[I_WO][((size_t)l * DM + k) * DM + c]);
        rep(ws, B27 + 1, WSF(WS_H)[(size_t)t * DM + c], (double)((const float*)(ws + WS_DBG + 65536))[i] + s, 0.002, 0.005); }
}
__global__ void chk_router(Args a, int l) {
    unsigned char* ws = a.ws; const unsigned i = blockIdx.x * blockDim.x + threadIdx.x; const unsigned r = hsh(i * 19 + 2 + l), r2 = hsh(r + 88); const int B29 = l * 45 + 29;
    const int t = r % T, c = r2 % DM; double ss = 0; for (int k = 0; k < DM; ++k) { const double x = WSF(WS_H)[(size_t)t * DM + k]; ss += x * x; } const double rstd = 1.0 / sqrt(ss / DM + 1e-6);
    rep(ws, B29 + 0, bf2f(WSB(WS_XN)[(size_t)t * DM + c]), WSF(WS_H)[(size_t)t * DM + c] * rstd * a.in[I_NMOE][l * DM + c], 0.006, 1e-3);
    double lg[16], mx = -1e300; for (int e = 0; e < 16; ++e) { double s = 0; for (int k = 0; k < DM; ++k) s += WSF(WS_H)[(size_t)t * DM + k] * rstd * a.in[I_NMOE][l * DM + k] * (double)a.in[I_WROUTER][((size_t)l * DM + k) * NE + e]; lg[e] = s; mx = s > mx ? s : mx; }
    double sum = 0; for (int e = 0; e < 16; ++e) { lg[e] = exp(lg[e] - mx); sum += lg[e]; }
    for (int e = 0; e < 16; ++e) rep(ws, B29 + 1, WSF(WS_AFF)[((size_t)(t >> 12) * NE + e) * SEQ + (t & 4095)], lg[e] / sum, 1e-4, 1e-6);
}
__global__ void chk_topk(Args a, int l) {
    unsigned char* ws = a.ws; const int be = blockIdx.x * blockDim.x + threadIdx.x; if (be >= NB * NE) return; const int b = be >> 4, e = be & 15; const int id = l * 45 + 31;
    const float* af = WSF(WS_AFF) + (size_t)be * SEQ; const int* so = (const int*)(ws + WS_SLOT); const int* mr = (const int*)(ws + WS_MROWS); const float* mg = WSF(WS_MGATE);
    int cnt = 0; float mins = 1e30f, maxu = -1.f; int bad = 0;
    for (int sp = 0; sp < SEQ; ++sp) { const int sl = so[(size_t)(b * SEQ + sp) * NE + e];
        if (sl >= 0) { ++cnt; mins = fminf(mins, af[sp]); if (sl < b * CAP || sl >= (b + 1) * CAP) bad = 1; else { if (mr[e * ROWS_E + sl] != b * SEQ + sp) bad = 1; if (mg[e * ROWS_E + sl] != af[sp]) bad = 1; } }
        else maxu = fmaxf(maxu, af[sp]); }
    if (cnt != CAP || bad || !(mins >= maxu)) ((int*)(ws + WS_DBG))[id] = 1;
}
__global__ void chk_moe(Args a, int l, int which) {
    unsigned char* ws = a.ws; const unsigned i = blockIdx.x * blockDim.x + threadIdx.x; const unsigned r = hsh(i * 23 + 6 + l + which), r2 = hsh(r + 1111); const int B32 = l * 45 + 32;
    const int e = r & 15, row = (r >> 4) % ROWS_E;
    if (which == 0) { const int f = r2 % FF, tok = ((const int*)(ws + WS_MROWS))[e * ROWS_E + row]; double g = 0, u = 0;
        for (int k = 0; k < DM; ++k) { const double x = bf2f(WSB(WS_XN)[(size_t)tok * DM + k]); g += x * (double)bfr(a.in[I_WG][(((size_t)l * NE + e) * DM + k) * FF + f]); u += x * (double)bfr(a.in[I_WU][(((size_t)l * NE + e) * DM + k) * FF + f]); }
        rep(ws, B32 + 0, bf2f(WSB(WS_HMOE)[((size_t)e * ROWS_E + row) * FF + f]), g / (1.0 + exp(-g)) * u, 0.02, 0.01);
    } else { const int d = r2 % DM; double s = 0; for (int f = 0; f < FF; ++f) s += (double)bf2f(WSB(WS_HMOE)[((size_t)e * ROWS_E + row) * FF + f]) * (double)bfr(a.in[I_WD][(((size_t)l * NE + e) * FF + f) * DM + d]);
        rep(ws, B32 + 1, bf2f(WSB(WS_YE)[((size_t)e * ROWS_E + row) * DM + d]), s * WSF(WS_MGATE)[e * ROWS_E + row], 0.02, 0.003); }
}
__global__ void chk_combine(Args a, int l) {
    unsigned char* ws = a.ws; const unsigned i = blockIdx.x * blockDim.x + threadIdx.x; const unsigned r = hsh(i * 13 + 3 + l + 1 * 1000), r2 = hsh(r + 555); const int B34 = l * 45 + 34;
    const int t = r % T, c = r2 % DM; double s = ((const float*)(ws + WS_DBG + 65536))[4096 + i];
    for (int e = 0; e < NE; ++e) { const int sl = ((const int*)(ws + WS_SLOT))[(size_t)t * NE + e]; if (sl >= 0) s += (double)bf2f(WSB(WS_YE)[((size_t)e * ROWS_E + sl) * DM + c]); }
    rep(ws, B34 + 0, WSF(WS_H)[(size_t)t * DM + c], s, 1e-4, 1e-4);
    double ss = 0; for (int k = 0; k < DM; ++k) { const double x = WSF(WS_H)[(size_t)t * DM + k]; ss += x * x; } const double rstd = 1.0 / sqrt(ss / DM + 1e-6);
    if (l + 1 < DEPTH) rep(ws, B34 + 1, bf2f(WSB(WS_XN)[(size_t)t * DM + c]), WSF(WS_H)[(size_t)t * DM + c] * rstd * a.in[I_NMIX][(l + 1) * DM + c], 0.006, 1e-3);
    else rep(ws, B34 + 1, a.out[(size_t)t * DM + c], WSF(WS_H)[(size_t)t * DM + c] * rstd * a.in[I_NFINAL][c], 1e-4, 1e-5);
}
__global__ void dbg_final(Args a) {
    const int* fl = (const int*)(a.ws + WS_DBG); int k = 0; for (int i = 1; i < 99; ++i) if (fl[i]) { k = i; break; }
    if (k == 0) return;
    const float al = sqrtf((float)k);
    for (size_t i = (size_t)blockIdx.x * blockDim.x + threadIdx.x; i < (size_t)T * DM; i += (size_t)gridDim.x * blockDim.x) a.out[i] = (hsh((unsigned)i) & 1) ? al : -al;
}
static void dbg_before_phase(int p, const Args& a, hipStream_t st) {
    if (p == 0) return; const int l = (p - 1) / 10, k = (p - 1) % 10;
    if (k == 4) hipLaunchKernelGGL(dbg_save_h, dim3(16), dim3(256), 0, st, a, 0, l);
    if (k == 9) hipLaunchKernelGGL(dbg_save_h, dim3(16), dim3(256), 0, st, a, 1, l);
}
static void dbg_after_phase(int p, const Args& a, hipStream_t st) {
    if (p == 0) { hipLaunchKernelGGL(chk_prologue, dim3(64), dim3(256), 0, st, a); return; }
    const int l = (p - 1) / 10, k = (p - 1) % 10;
    if (k == 0) hipLaunchKernelGGL(chk_inproj, dim3(32), dim3(256), 0, st, a, l);
    if (k == 1) hipLaunchKernelGGL(chk_mid, dim3(32), dim3(256), 0, st, a, l);
    if (k == 2) hipLaunchKernelGGL(chk_dft_mla, dim3(128), dim3(256), 0, st, a, l);
    if (k == 3) hipLaunchKernelGGL(chk_merge_wo, dim3(16), dim3(256), 0, st, a, l, 0);
    if (k == 4) hipLaunchKernelGGL(chk_merge_wo, dim3(16), dim3(256), 0, st, a, l, 1);
    if (k == 5) hipLaunchKernelGGL(chk_router, dim3(8), dim3(256), 0, st, a, l);
    if (k == 6) hipLaunchKernelGGL(chk_topk, dim3(1), dim3(64), 0, st, a, l);
    if (k == 7) hipLaunchKernelGGL(chk_moe, dim3(16), dim3(256), 0, st, a, l, 0);
    if (k == 8) hipLaunchKernelGGL(chk_moe, dim3(16), dim3(256), 0, st, a, l, 1);
    if (k == 9) hipLaunchKernelGGL(chk_combine, dim3(16), dim3(256), 0, st, a, l);
}
static void dbg_finalize(const Args& a, hipStream_t st) { hipLaunchKernelGGL(dbg_final, dim3(1024), dim3(256), 0, st, a); }
#endif
extern "C" void kernel_launch(void* const* d_in, const int* in_sizes, int n_in, void* d_out, int out_size, void* d_ws, size_t ws_size, hipStream_t stream) {
    static int grid = 0;
    if (grid == 0) {
        if (n_in != 17 || out_size != T * DM || ws_size < WS_END) { fprintf(stderr, "kernel_launch: unexpected shapes (n_in %d out %d ws %zu)\n", n_in, out_size, ws_size); grid = -1; return; }
        int dev = 0, cus = 0, per_cu = 0;
        if (hipGetDevice(&dev) != hipSuccess || hipDeviceGetAttribute(&cus, hipDeviceAttributeMultiprocessorCount, dev) != hipSuccess) { grid = -1; return; }
        if (hipFuncSetAttribute((const void*)fwd, hipFuncAttributeMaxDynamicSharedMemorySize, LDS_BYTES) != hipSuccess) { fprintf(stderr, "kernel_launch: hipFuncSetAttribute failed\n"); grid = -1; return; }
        if (hipOccupancyMaxActiveBlocksPerMultiprocessor(&per_cu, (const void*)fwd, 512, LDS_BYTES) != hipSuccess || per_cu < 1) { fprintf(stderr, "kernel_launch: occupancy query says %d\n", per_cu); }
        (void)hipGetLastError();
        grid = cus;
    }
    if (grid < 0) return;
    (void)hipMemsetAsync((char*)d_ws + WS_CTL, 0, CTL_ZERO_BYTES, stream);
    Args a{};
    for (int i = 0; i < 17; ++i) a.in[i] = (const float*)d_in[i];
    a.out = (float*)d_out; a.ws = (unsigned char*)d_ws;
#if MK_DEBUG
    (void)hipMemsetAsync((char*)d_ws + WS_DBG, 0, 4096, stream);
    for (int p = 0; p < N_PHASES; ++p) {
        a.ph_lo = p; a.ph_hi = p + 1;
        dbg_before_phase(p, a, stream);
        hipLaunchKernelGGL(fwd, dim3(grid), dim3(512), LDS_BYTES, stream, a);
        dbg_after_phase(p, a, stream);
    }
    dbg_finalize(a, stream);
#else
    a.ph_lo = 0; a.ph_hi = N_PHASES;
    hipLaunchKernelGGL(fwd, dim3(grid), dim3(512), LDS_BYTES, stream, a);
#endif
}
```

```cpp
#include <hip/hip_runtime.h>
#include <cstdio>
#include <cstdint>

#ifndef MK_DEBUG
#define MK_DEBUG 0
#endif

#define GAS __attribute__((address_space(1)))
#define LAS __attribute__((address_space(3)))
typedef unsigned short bf16_t;
typedef short bf16x8 __attribute__((ext_vector_type(8)));
typedef short s16x4 __attribute__((ext_vector_type(4)));
typedef float f32x4 __attribute__((ext_vector_type(4)));
typedef float f32x2 __attribute__((ext_vector_type(2)));
typedef float f32x16 __attribute__((ext_vector_type(16)));
typedef unsigned u32x4 __attribute__((ext_vector_type(4)));
typedef unsigned u32x2 __attribute__((ext_vector_type(2)));

constexpr int DM = 2048, NB = 4, SEQ = 4096, T = NB * SEQ, DEPTH = 2;
constexpr int IN_COLS = 10912, NIN = 11008;
constexpr int QL = 448, QLP = 512, KVL = 160, KVLP = 256;
constexpr int NE = 16, FF = 2048, CAP = 512, ROWS_E = NB * CAP;
constexpr float RMS_EPS = 1e-6f;
constexpr float LOG2E = 1.4426950408889634f;

constexpr size_t MiB = 1u << 20;
constexpr size_t WS_CTL = 0, CTL_ZERO_BYTES = 64 * 1024;
constexpr size_t WS_DBG = 512 * 1024;
constexpr size_t WS_ROPEC = 1 * MiB, WS_ROPES = WS_ROPEC + 512 * 1024;
constexpr size_t WS_WCH = 2 * MiB;
constexpr size_t WS_AFF = 3 * MiB;
constexpr size_t WS_MROWS = 4 * MiB, WS_MGATE = WS_MROWS + 256 * 1024;
constexpr size_t WS_SLOT = 5 * MiB;
constexpr size_t WS_SSQQ = 6 * MiB, WS_SSQKV = WS_SSQQ + 512 * 1024;
constexpr size_t WS_ADFT = 8 * MiB;
constexpr size_t WS_W = 72 * MiB, W_LAYER = 450 * MiB;
constexpr size_t WO_IN = 0, WO_UQ = 43 * MiB, WO_UKV = WO_UQ + 3 * MiB / 2, WO_BR = WO_UKV + 1 * MiB, WO_O = WO_BR + 12 * MiB, WO_GU = WO_O + 8 * MiB, WO_D = WO_GU + 256 * MiB;
static_assert(WO_D + 128 * MiB <= W_LAYER, "weights");
constexpr size_t WS_H = 972 * MiB;
constexpr size_t WS_XN = 1100 * MiB;
constexpr size_t WS_QNA = 1164 * MiB, WS_KNA = 1196 * MiB, WS_VT = 1228 * MiB, WS_UF = 1260 * MiB;
constexpr size_t WS_GATES = 1292 * MiB;
constexpr size_t WS_CQ = 1484 * MiB, WS_CKV = 1500 * MiB, WS_KPE = 1508 * MiB;
constexpr size_t WS_ZT = 1512 * MiB;
constexpr size_t WS_QMLA = 1576 * MiB, WS_KVMLA = 1624 * MiB;
constexpr size_t WS_YNA = 1688 * MiB, WS_YMLA = 1720 * MiB, WS_YF = 1752 * MiB;
constexpr size_t WS_MPART = 1784 * MiB;
constexpr size_t WS_MERGED = 1912 * MiB;
constexpr size_t WS_HMOE = 1164 * MiB;
constexpr size_t WS_YE = 1292 * MiB;
constexpr size_t WS_END = 1976 * MiB;

constexpr int RING_BYTES = 131072;
constexpr int MISC_OFF = 135168;
constexpr int LDS_BYTES = 147456;

__device__ __forceinline__ float bf2f(bf16_t b) { return __uint_as_float(((unsigned)b) << 16); }
__device__ __forceinline__ unsigned f2bf(float f) { unsigned u = __float_as_uint(f); return (u + 0x7fffu + ((u >> 16) & 1u)) >> 16; }
__device__ __forceinline__ unsigned cvt_pk_bf16(float lo, float hi) { unsigned r; asm volatile("s_nop 0\n\tv_cvt_pk_bf16_f32 %0, %1, %2" : "=v"(r) : "v"(lo), "v"(hi)); return r; }
__device__ __forceinline__ float wave_sum(float v) {
#pragma unroll
    for (int o = 1; o < 64; o <<= 1) v += __shfl_xor(v, o);
    return v;
}
#define LDS_WAIT() asm volatile("s_waitcnt lgkmcnt(0)" ::: "memory")
#define VM_WAIT() asm volatile("s_waitcnt vmcnt(0)" ::: "memory")

#define XB_TMO      128
#define XB_XCNT(j)  (256  + 64 * (j))
#define XB_XSUB(j)  (1280 + 64 * (j))
#define XB_XGEN(j)  (2304 + 64 * (j))
#define XB_TOP      3328
#define XB_TOPGEN   3392
#define XCD_BAR_WORDS 3456
#define XB_SPIN_CAP (1u << 18)
__device__ __forceinline__ unsigned xb_ld(unsigned* p)              { return __hip_atomic_load(p, __ATOMIC_RELAXED, __HIP_MEMORY_SCOPE_AGENT); }
__device__ __forceinline__ unsigned xb_add(unsigned* p, unsigned v) { return __hip_atomic_fetch_add(p, v, __ATOMIC_RELAXED, __HIP_MEMORY_SCOPE_AGENT); }
__device__ __forceinline__ unsigned xb_xcc_id() { return (unsigned)__builtin_amdgcn_s_getreg((3 << 11) | 20) & 0xFu; }
#define XB_SPIN(cond, bar) do { unsigned _sp = 0; while (cond) { __builtin_amdgcn_s_sleep(1); \
    if ((++_sp & 255u) == 0u) { if (xb_ld(&(bar)[XB_TMO])) break; if (_sp > XB_SPIN_CAP) { atomicAdd(&(bar)[XB_TMO], 1u); break; } } } } while (0)
struct XcdBarrier { unsigned* bar; unsigned x; volatile LAS unsigned* st; };
__device__ __forceinline__ XcdBarrier xcd_barrier_post(unsigned* bar, volatile LAS unsigned* st) {
    XcdBarrier b; b.bar = bar; b.x = xb_xcc_id(); b.st = st;
    if (threadIdx.x == 0) (void)xb_add(&bar[XB_XCNT(b.x)], 1u);
    return b;
}
__device__ __forceinline__ void xcd_barrier_complete(unsigned* bar, unsigned x, unsigned& nloc, unsigned& nx) {
    const unsigned G = gridDim.x * gridDim.y * gridDim.z;
    unsigned sum, cnt, mine, sp = 0u;
    for (;;) {
        sum = 0u; cnt = 0u; mine = 0u;
#pragma unroll
        for (unsigned j = 0; j < 16; ++j) { const unsigned c = xb_ld(&bar[XB_XCNT(j)]); sum += c; cnt += (c > 0u) ? 1u : 0u; mine = (j == x) ? c : mine; }
        if (sum == G) break;
        __builtin_amdgcn_s_sleep(1);
        if ((++sp & 255u) == 0u) { if (xb_ld(&bar[XB_TMO])) break; if (sp > XB_SPIN_CAP) { atomicAdd(&bar[XB_TMO], 1u); break; } }
    }
    nloc = mine > 0u ? mine : 1u; nx = cnt > 0u ? cnt : 1u;
}
template <bool FIRST> __device__ __forceinline__ void xcd_barrier(const XcdBarrier& b) {
    asm volatile("s_waitcnt vmcnt(0)" ::: "memory");
    __syncthreads();
    if (threadIdx.x == 0) {
        unsigned* bar = b.bar;
        __builtin_amdgcn_s_waitcnt(0);
        unsigned nloc = b.st[0], nx = b.st[1];
        if constexpr (FIRST) { if (nloc == 0u) { xcd_barrier_complete(bar, b.x, nloc, nx); b.st[0] = nloc; b.st[1] = nx; } }
        else if (nloc == 0u) { atomicAdd(&bar[XB_TMO], 1u); nloc = 1u; nx = 1u; }
        const unsigned old = xb_add(&bar[XB_XSUB(b.x)], 1u);
        const unsigned gen = old / nloc;
        if (old + 1u == (gen + 1u) * nloc) {
            __builtin_amdgcn_fence(__ATOMIC_RELEASE, "agent");
            asm volatile("s_waitcnt vmcnt(0)" ::: "memory");
            const unsigned og = xb_add(&bar[XB_TOP], 1u);
            const unsigned tg = og / nx;
            if (og + 1u == (tg + 1u) * nx) xb_add(&bar[XB_TOPGEN], 1u);
            else XB_SPIN(xb_ld(&bar[XB_TOPGEN]) == tg, bar);
            __builtin_amdgcn_fence(__ATOMIC_ACQUIRE, "agent");
            xb_add(&bar[XB_XGEN(b.x)], 1u);
            asm volatile("s_waitcnt vmcnt(0)" ::: "memory");
        } else {
            XB_SPIN(xb_ld(&bar[XB_XGEN(b.x)]) == gen, bar);
            __builtin_amdgcn_fence(__ATOMIC_ACQUIRE, "agent");
            asm volatile("s_waitcnt vmcnt(0)" ::: "memory");
        }
    }
    __syncthreads();
}

namespace pg8 {
constexpr int BM = 256, BK = 64, HALF = 128, HTB = HALF * BK * 2, STAGE_BYTES = 8 * HTB, NXCD = 8, WGM = 8;
__host__ __device__ __forceinline__ int lds_byte(int r, int c) { const int st = (r >> 4) * 2 + (c >> 5), rr = r & 15, cc = c & 31, ob = rr * 64 + cc * 2; return st * 1024 + (ob ^ (((ob >> 9) & 1) << 5)); }
__host__ __device__ __forceinline__ void stage_rc(int b, int& R, int& C) { const int st = b / 1024, sb = b % 1024, swz = sb ^ (((sb >> 9) & 1) << 5); R = (st >> 1) * 16 + swz / 64; C = (st & 1) * 32 + (swz % 64) / 2; }
__host__ __device__ __forceinline__ int perm32(int rho) { const int n = rho >> 4, i = rho & 15; return 8 * (i >> 2) + 4 * n + (i & 3); }

struct Unit { const char* A; const char* B; const int* rows; int orow, ocol, aux; };
struct Shape { int K, lda, ldb; unsigned bhalf; };

__device__ __forceinline__ void tile_order(int L, int nM, int nN, int& pm, int& pn) {
    const int nwg = nM * nN; int wgid = L;
    { const int q = nwg / NXCD, r = nwg % NXCD, xcd = wgid % NXCD, off = wgid / NXCD; wgid = (xcd < r ? xcd * (q + 1) : r * (q + 1) + (xcd - r) * q) + off; }
    const int nig = WGM * nN, gid = wgid / nig, fm = gid * WGM, gsz = (nM - fm) < WGM ? (nM - fm) : WGM;
    pm = fm + ((wgid % nig) % gsz); pn = (wgid % nig) / gsz;
}

template <class T, class = void> struct EpiChain { static constexpr bool value = false; };
template <class T> struct EpiChain<T, decltype((void)T::CHAIN)> { static constexpr bool value = T::CHAIN; };
template <class Epi, class Sched, bool GATHER>
__device__ __forceinline__ void gemm_phase(LAS unsigned char* lds, const Shape g, const Sched& S, const Epi& E) {
    int tid_ = threadIdx.x; asm volatile("" : "+v"(tid_));
    const int tid = tid_, wid = __builtin_amdgcn_readfirstlane(tid >> 6), lane = tid & 63, wr = wid >> 2, wc = wid & 3, fr = lane & 15, fq = lane >> 4;
    int Kop = g.K; asm volatile("" : "+s"(Kop));
    const int K = Kop, nt = K / BK;
    unsigned vAc[2][2], vAn[2][2], vB[2]; int Rr[2], Cc[2];
#pragma unroll
    for (int i = 0; i < 2; ++i) { int R, C; stage_rc(tid * 16 + i * 8192, R, C); const int Rb = (R & ~31) + perm32(R & 31);
        Rr[i] = R; Cc[i] = C;
        vAc[0][i] = (unsigned)(R * g.lda + C) * 2u; vAc[1][i] = vAc[0][i];
        vB[i] = (unsigned)(Rb * g.ldb + C) * 2u; }
    const size_t hA = GATHER ? (size_t)0 : (size_t)HALF * g.lda * 2, hB = (size_t)g.bhalf;
    const size_t kstep = (size_t)(BK * 2);
    const unsigned ldsw = (unsigned)wid * 1024u;
    const int aoff = lds_byte(wr * 64 + fr, fq * 8), boff = lds_byte(wc * 32 + fr, fq * 8);
#define PG8_SA(b, h) (((b) * 2 + (h)) * HTB)
#define PG8_SB(b, h) ((4 + (b) * 2 + (h)) * HTB)
#define PG8_STAGE(bufoff, gbase, voff) do { _Pragma("unroll") for (int _i = 0; _i < 2; ++_i) \
        __builtin_amdgcn_global_load_lds((const unsigned*)((const char*)(gbase) + (voff)[_i]), (LAS unsigned*)(lds + (bufoff) + ldsw + _i * 8192), 16, 0, 0); } while (0)
#define PG8_LDA(dst, b, h) do { _Pragma("unroll") for (int m = 0; m < 4; ++m) _Pragma("unroll") for (int k = 0; k < 2; ++k) dst[m][k] = *(const LAS bf16x8*)(lds + PG8_SA(b, h) + aoff + m * 2048 + k * 1024); } while (0)
#define PG8_LDB(dst, b, h) do { _Pragma("unroll") for (int n = 0; n < 2; ++n) _Pragma("unroll") for (int k = 0; k < 2; ++k) dst[n][k] = *(const LAS bf16x8*)(lds + PG8_SB(b, h) + boff + n * 2048 + k * 1024); } while (0)
#define PG8_MMA(ai, bj, At, Bt) do { __builtin_amdgcn_s_setprio(1); _Pragma("unroll") for (int m = 0; m < 4; ++m) _Pragma("unroll") for (int n = 0; n < 2; ++n) _Pragma("unroll") for (int k = 0; k < 2; ++k) \
        acc[ai][bj][m][n] = __builtin_amdgcn_mfma_f32_16x16x32_bf16(Bt[n][k], At[m][k], acc[ai][bj][m][n], 0, 0, 0); __builtin_amdgcn_s_setprio(0); } while (0)
#define PG8_WAIT_V(n) asm volatile("s_waitcnt vmcnt(" #n ")" ::: "memory")
#define PG8_WAIT_L(n) asm volatile("s_waitcnt lgkmcnt(" #n ")" ::: "memory")
#define PG8_BAR __builtin_amdgcn_s_barrier()
#define PG8_SCHED __builtin_amdgcn_sched_barrier(0)
    Unit cur, nxt; int ui = 0;
    if (!S.next(0, cur)) return;
    if constexpr (GATHER) {
#pragma unroll
        for (int h = 0; h < 2; ++h)
#pragma unroll
            for (int i = 0; i < 2; ++i) vAc[h][i] = (unsigned)cur.rows[h * HALF + Rr[i]] * (unsigned)(g.lda * 2) + (unsigned)Cc[i] * 2u;
    }
    f32x4 acc[2][2][4][2];
#pragma unroll
    for (int a = 0; a < 2; ++a)
#pragma unroll
        for (int b = 0; b < 2; ++b)
#pragma unroll
            for (int m = 0; m < 4; ++m)
#pragma unroll
                for (int n = 0; n < 2; ++n) acc[a][b][m][n] = (f32x4){0.f, 0.f, 0.f, 0.f};
    bf16x8 At[4][2], B0[2][2], B1[2][2];
    const char* cA = cur.A; const char* cB = cur.B;
    PG8_STAGE(PG8_SB(0, 0), cB, vB); PG8_STAGE(PG8_SB(0, 1), cB + hB, vB); PG8_STAGE(PG8_SA(0, 0), cA, vAc[0]); PG8_STAGE(PG8_SA(0, 1), cA + hA, vAc[1]);
    if (wr == 1) PG8_BAR;
    PG8_WAIT_V(2); PG8_BAR;
    PG8_STAGE(PG8_SB(1, 0), cB + kstep, vB); PG8_STAGE(PG8_SA(1, 0), cA + kstep, vAc[0]); PG8_STAGE(PG8_SB(1, 1), cB + hB + kstep, vB);
    PG8_WAIT_V(6); PG8_BAR;
    for (;;) {
        const bool has_next = S.next(ui + 1, nxt);
        const char* nA = has_next ? nxt.A : cA; const char* nB = has_next ? nxt.B : cB;
#pragma unroll
        for (int h = 0; h < 2; ++h)
#pragma unroll
            for (int i = 0; i < 2; ++i) vAn[h][i] = vAc[h][i];
        if constexpr (GATHER) { if (has_next) {
#pragma unroll
            for (int h = 0; h < 2; ++h)
#pragma unroll
                for (int i = 0; i < 2; ++i) vAn[h][i] = (unsigned)nxt.rows[h * HALF + Rr[i]] * (unsigned)(g.lda * 2) + (unsigned)Cc[i] * 2u; } }
#pragma unroll 1
        for (int t = 0; t < nt; t += 2) {
            const bool last = (t == nt - 2);
            const char* a1 = cA + (size_t)(t + 1) * kstep;
            const char* a2 = last ? nA : cA + (size_t)(t + 2) * kstep; const char* b2 = last ? nB : cB + (size_t)(t + 2) * kstep;
            const char* a3 = a2 + kstep; const char* b3 = b2 + kstep;
            unsigned vA2[2][2];
#pragma unroll
            for (int h = 0; h < 2; ++h)
#pragma unroll
                for (int i = 0; i < 2; ++i) vA2[h][i] = (GATHER && last) ? vAn[h][i] : vAc[h][i];
            PG8_LDB(B0, 0, 0); PG8_LDB(B1, 0, 1); PG8_SCHED; PG8_LDA(At, 0, 0); PG8_STAGE(PG8_SA(1, 1), a1 + hA, vAc[1]);
            PG8_WAIT_V(8); PG8_WAIT_L(0); PG8_BAR; PG8_MMA(0, 0, At, B0); PG8_MMA(0, 1, At, B1); PG8_BAR; PG8_SCHED;
            PG8_LDA(At, 0, 1); PG8_STAGE(PG8_SB(0, 0), b2, vB); PG8_STAGE(PG8_SB(0, 1), b2 + hB, vB); PG8_STAGE(PG8_SA(0, 0), a2, vA2[0]);
            PG8_WAIT_V(8); PG8_WAIT_L(0); PG8_BAR; PG8_MMA(1, 0, At, B0); PG8_MMA(1, 1, At, B1); PG8_BAR; PG8_SCHED;
            PG8_LDB(B0, 1, 0); PG8_LDB(B1, 1, 1); PG8_SCHED; PG8_LDA(At, 1, 0); PG8_STAGE(PG8_SA(0, 1), a2 + hA, vA2[1]);
            PG8_WAIT_V(8); PG8_WAIT_L(0); PG8_BAR; PG8_MMA(0, 0, At, B0); PG8_MMA(0, 1, At, B1); PG8_BAR; PG8_SCHED;
            PG8_LDA(At, 1, 1); PG8_STAGE(PG8_SB(1, 0), b3, vB); PG8_STAGE(PG8_SB(1, 1), b3 + hB, vB); PG8_STAGE(PG8_SA(1, 0), a3, vA2[0]);
            PG8_WAIT_V(8); PG8_WAIT_L(0); PG8_BAR; PG8_MMA(1, 0, At, B0); PG8_MMA(1, 1, At, B1); PG8_BAR; PG8_SCHED;
        }
        if (wr == 0) PG8_BAR;
        E(acc, cur, wr, wc, fr, fq);
        if (!has_next) break;
        bool zero_acc = true;
        if constexpr (EpiChain<Epi>::value) zero_acc = !E.keep(cur);
        if (zero_acc) {
#pragma unroll
        for (int a = 0; a < 2; ++a)
#pragma unroll
            for (int b = 0; b < 2; ++b)
#pragma unroll
                for (int m = 0; m < 4; ++m)
#pragma unroll
                    for (int n = 0; n < 2; ++n) acc[a][b][m][n] = (f32x4){0.f, 0.f, 0.f, 0.f};
        }
        cur = nxt; cA = nA; cB = nB; ++ui;
#pragma unroll
        for (int h = 0; h < 2; ++h)
#pragma unroll
            for (int i = 0; i < 2; ++i) vAc[h][i] = vAn[h][i];
        if (wr == 1) PG8_BAR;
    }
    PG8_WAIT_V(0);
    PG8_BAR;
#undef PG8_SA
#undef PG8_SB
#undef PG8_STAGE
#undef PG8_LDA
#undef PG8_LDB
#undef PG8_MMA
#undef PG8_WAIT_V
#undef PG8_WAIT_L
#undef PG8_BAR
#undef PG8_SCHED
}
}
using pg8::Unit; using pg8::Shape;

struct SchedGrid {
    const char* A; const char* B; size_t a_tile, b_tile; int nM, nN, G, c;
    __device__ __forceinline__ bool next(int i, Unit& u) const {
        const int L = i * G + c; if (L >= nM * nN) return false;
        int pm, pn; pg8::tile_order(L, nM, nN, pm, pn);
        u.A = A + (size_t)pm * a_tile; u.B = B + (size_t)pn * b_tile; u.rows = nullptr; u.orow = pm * 256; u.ocol = pn * 256; u.aux = 0; return true;
    }
};
struct SchedBranch {
    const char* A[3]; const char* B; int G, c;
    __device__ __forceinline__ bool next(int i, Unit& u) const {
        const int round = i / 3, br = i - round * 3; const int L = round * G + c; if (L >= 512) return false;
        int pm, pn; pg8::tile_order(L, 64, 8, pm, pn);
        const char* a = br == 0 ? A[0] : (br == 1 ? A[1] : A[2]);
        u.A = a + (size_t)pm * 256 * 1024 * 2; u.B = B + ((size_t)br * 2048 + (size_t)pn * 256) * 1024 * 2; u.rows = nullptr; u.orow = pm * 256; u.ocol = pn * 256; u.aux = br; return true;
    }
};
struct SchedF1 {
    const char* Wch; const char* uf; int G, c;
    __device__ __forceinline__ bool next(int i, Unit& u) const {
        const int L = i * G + c; if (L >= 512) return false;
        const int pn = L & 15, pm = (L >> 4) & 1, g = (L >> 5) & 3, b = L >> 7;
        u.A = Wch + (size_t)pm * 256 * 256 * 2; u.B = uf + (((size_t)b * SEQ + pn * 256) * 1024 + g * 256) * 2; u.rows = nullptr; u.orow = pm; u.ocol = pn * 256; u.aux = b * 4 + g; return true;
    }
};
struct SchedDft {
    const char* adft; const char* zt; int c;
    __device__ __forceinline__ bool next(int i, Unit& u) const {
        if (i > 0 || c >= 256) return false;
        const int pn = c & 3, pm = (c >> 2) & 15, b = c >> 6;
        u.A = adft + (size_t)pm * 256 * 8192 * 2; u.B = zt + ((size_t)b * 1024 + pn * 256) * 8192 * 2; u.rows = nullptr; u.orow = b * SEQ + pm * 256; u.ocol = pn * 256; u.aux = 0; return true;
    }
};
struct SchedMoe1 {
    const char* xn; const int* rows; const char* wgu; int G, c;
    __device__ __forceinline__ bool next(int i, Unit& u) const {
        const int L = i * G + c; if (L >= 2048) return false;
        const int pm = L & 7, pn = (L >> 3) & 15, e = L >> 7;
        u.A = xn; u.rows = rows + e * ROWS_E + pm * 256; u.B = wgu + (size_t)e * (2 * FF * DM * 2) + (size_t)pn * 128 * DM * 2; u.orow = e * ROWS_E + pm * 256; u.ocol = pn * 128; u.aux = e; return true;
    }
};
struct SchedMoe2 {
    const char* hm; const char* wd; int G, c;
    __device__ __forceinline__ bool next(int i, Unit& u) const {
        const int L = i * G + c; if (L >= 1024) return false;
        const int pm = L & 7, pn = (L >> 3) & 7, e = L >> 6;
        u.A = hm + ((size_t)e * ROWS_E + pm * 256) * FF * 2; u.B = wd + ((size_t)e * DM + pn * 256) * FF * 2; u.rows = nullptr; u.orow = e * ROWS_E + pm * 256; u.ocol = pn * 256; u.aux = e; return true;
    }
};

#define EPI_ARGS f32x4 (&acc)[2][2][4][2], const Unit& u, int wr, int wc, int fr, int fq
#define FOR_AI_M _Pragma("unroll") for (int ai = 0; ai < 2; ++ai) _Pragma("unroll") for (int m = 0; m < 4; ++m)
__device__ __forceinline__ u32x4 pack8(const f32x4 a, const f32x4 b) { u32x4 w; w.x = cvt_pk_bf16(a[0], a[1]); w.y = cvt_pk_bf16(a[2], a[3]); w.z = cvt_pk_bf16(b[0], b[1]); w.w = cvt_pk_bf16(b[2], b[3]); return w; }
__device__ __forceinline__ void unpack8(const u32x4 w, f32x4& a, f32x4& b) {
    a[0] = __uint_as_float(w.x << 16); a[1] = __uint_as_float(w.x & 0xffff0000u); a[2] = __uint_as_float(w.y << 16); a[3] = __uint_as_float(w.y & 0xffff0000u);
    b[0] = __uint_as_float(w.z << 16); b[1] = __uint_as_float(w.z & 0xffff0000u); b[2] = __uint_as_float(w.w << 16); b[3] = __uint_as_float(w.w & 0xffff0000u); }
__device__ __forceinline__ void store_tile_bf16(EPI_ARGS, bf16_t* O, int ldc, int orow, int ocol, float sc) {
    const int row0 = orow + wr * 64 + fr, col0 = ocol + wc * 32 + 8 * fq;
    FOR_AI_M { bf16_t* rowp = O + (size_t)(row0 + ai * 128 + m * 16) * ldc + col0;
#pragma unroll
        for (int bj = 0; bj < 2; ++bj) *(u32x4*)(rowp + bj * 128) = pack8(acc[ai][bj][m][0] * sc, acc[ai][bj][m][1] * sc); }
}
__device__ __forceinline__ void rope8(f32x4& v0, f32x4& v1, const float* ropec, const float* ropes, int s, int jj0) {
    const f32x4 c = *(const f32x4*)(ropec + s * 32 + jj0), sn = *(const f32x4*)(ropes + s * 32 + jj0);
    f32x4 o0, o1;
    o0[0] = v0[0] * c[0] - v0[1] * sn[0]; o0[1] = v0[1] * c[0] + v0[0] * sn[0];
    o0[2] = v0[2] * c[1] - v0[3] * sn[1]; o0[3] = v0[3] * c[1] + v0[2] * sn[1];
    o1[0] = v1[0] * c[2] - v1[1] * sn[2]; o1[1] = v1[1] * c[2] + v1[0] * sn[2];
    o1[2] = v1[2] * c[3] - v1[3] * sn[3]; o1[3] = v1[3] * c[3] + v1[2] * sn[3];
    v0 = o0; v1 = o1;
}

struct EpiInProj {
    bf16_t *Qna, *Kna, *Vt, *uf, *gates, *cq, *ckv, *kpe; const float *bgate, *ropec, *ropes; float *ssqq, *ssqkv;
    __device__ __forceinline__ void operator()(EPI_ARGS) const {
        const int pn = u.ocol >> 8;
        if (pn < 4) { store_tile_bf16(acc, u, wr, wc, fr, fq, Qna, 1024, u.orow, u.ocol, 0.125f); return; }
        if (pn < 8) { store_tile_bf16(acc, u, wr, wc, fr, fq, Kna, 1024, u.orow, u.ocol - 1024, 1.f); return; }
        if (pn < 12) {
            const int b = u.orow >> 12, s0 = (u.orow & 4095) + wr * 64 + fr;
#pragma unroll
            for (int bj = 0; bj < 2; ++bj) { const int head = (pn - 8) * 4 + bj * 2 + (wc >> 1), d0 = 32 * (wc & 1) + 8 * fq;
                bf16_t* vp = Vt + ((size_t)(b * 16 + head) * 64 + d0) * SEQ + s0;
                FOR_AI_M {
#pragma unroll
                    for (int n = 0; n < 2; ++n)
#pragma unroll
                        for (int j = 0; j < 4; ++j) vp[(size_t)(4 * n + j) * SEQ + ai * 128 + m * 16] = (bf16_t)f2bf(acc[ai][bj][m][n][j]); } }
            return; }
        if (pn < 16) { store_tile_bf16(acc, u, wr, wc, fr, fq, uf, 1024, u.orow, u.ocol - 3072, 1.f); return; }
        if (pn < 40) {
            const int row0 = u.orow + wr * 64 + fr, col0 = (u.ocol - 4096) + wc * 32 + 8 * fq;
#pragma unroll
            for (int bj = 0; bj < 2; ++bj) { const f32x4 b0 = *(const f32x4*)(bgate + col0 + bj * 128), b1 = *(const f32x4*)(bgate + col0 + bj * 128 + 4);
                FOR_AI_M { f32x4 v0 = acc[ai][bj][m][0] + b0, v1 = acc[ai][bj][m][1] + b1;
#pragma unroll
                    for (int j = 0; j < 4; ++j) { v0[j] = __builtin_amdgcn_rcpf(1.f + __expf(-v0[j])); v1[j] = __builtin_amdgcn_rcpf(1.f + __expf(-v1[j])); }
                    *(u32x4*)(gates + (size_t)(row0 + ai * 128 + m * 16) * 6144 + col0 + bj * 128) = pack8(v0, v1); } }
            return; }
        if (pn < 42) {
            store_tile_bf16(acc, u, wr, wc, fr, fq, cq, QLP, u.orow, u.ocol - 10240, 1.f);
            const int row0 = u.orow + wr * 64 + fr, slot = (pn - 40) * 4 + wc;
            FOR_AI_M { float s = 0.f;
#pragma unroll
                for (int bj = 0; bj < 2; ++bj)
#pragma unroll
                    for (int n = 0; n < 2; ++n) { const f32x4 x = acc[ai][bj][m][n]; s += (x[0] * x[0] + x[1] * x[1]) + (x[2] * x[2] + x[3] * x[3]); }
                s += __shfl_xor(s, 16); s += __shfl_xor(s, 32);
                if (fq == 0) ssqq[(size_t)(row0 + ai * 128 + m * 16) * 8 + slot] = s; }
            return; }
        {
            const int row0 = u.orow + wr * 64 + fr, cl = wc * 32 + 8 * fq;
            FOR_AI_M { const int row = row0 + ai * 128 + m * 16; float s = 0.f;
                *(u32x4*)(ckv + (size_t)row * KVLP + cl) = pack8(acc[ai][0][m][0], acc[ai][0][m][1]);
                { const f32x4 x = acc[ai][0][m][0], y = acc[ai][0][m][1]; s += (x[0] * x[0] + x[1] * x[1]) + (x[2] * x[2] + x[3] * x[3]) + (y[0] * y[0] + y[1] * y[1]) + (y[2] * y[2] + y[3] * y[3]); }
                if (wc == 0) {
                    *(u32x4*)(ckv + (size_t)row * KVLP + 128 + cl) = pack8(acc[ai][1][m][0], acc[ai][1][m][1]);
                    const f32x4 x = acc[ai][1][m][0], y = acc[ai][1][m][1]; s += (x[0] * x[0] + x[1] * x[1]) + (x[2] * x[2] + x[3] * x[3]) + (y[0] * y[0] + y[1] * y[1]) + (y[2] * y[2] + y[3] * y[3]);
                } else {
                    *(u32x4*)(ckv + (size_t)row * KVLP + 128 + cl) = pack8(acc[ai][1][m][0] * 0.f, acc[ai][1][m][1] * 0.f);
                    if (wc <= 2) { f32x4 v0 = acc[ai][1][m][0], v1 = acc[ai][1][m][1]; const int kc = cl - 32;
                        rope8(v0, v1, ropec, ropes, row & 4095, kc >> 1);
                        *(u32x4*)(kpe + (size_t)row * 64 + kc) = pack8(v0, v1); }
                }
                s += __shfl_xor(s, 16); s += __shfl_xor(s, 32);
                if (fq == 0) ssqkv[(size_t)row * 4 + wc] = s; }
        }
    }
};
struct EpiQup {
    bf16_t* qmla; const float *ssqq, *ropec, *ropes;
    __device__ __forceinline__ void operator()(EPI_ARGS) const {
        const int row0 = u.orow + wr * 64 + fr, col0 = u.ocol + wc * 32 + 8 * fq;
        FOR_AI_M { const int row = row0 + ai * 128 + m * 16;
            const f32x4 p0 = *(const f32x4*)(ssqq + (size_t)row * 8), p1 = *(const f32x4*)(ssqq + (size_t)row * 8 + 4);
            const float ss = ((p0[0] + p0[1]) + (p0[2] + p0[3])) + ((p1[0] + p1[1]) + (p1[2] + p1[3]));
            const float rstd = 1.0f / sqrtf(ss * (1.f / QL) + RMS_EPS);
#pragma unroll
            for (int bj = 0; bj < 2; ++bj) { const int col = col0 + bj * 128, c8 = col % 192;
                f32x4 v0 = acc[ai][bj][m][0] * rstd, v1 = acc[ai][bj][m][1] * rstd;
                if (c8 >= 128) rope8(v0, v1, ropec, ropes, row & 4095, (c8 - 128) >> 1);
                *(u32x4*)(qmla + (size_t)row * 1536 + col) = pack8(v0, v1); } }
    }
};
struct EpiKVup {
    bf16_t* kv; const float* ssqkv;
    __device__ __forceinline__ void operator()(EPI_ARGS) const {
        const int row0 = u.orow + wr * 64 + fr, col0 = u.ocol + wc * 32 + 8 * fq;
        FOR_AI_M { const int row = row0 + ai * 128 + m * 16;
            const f32x4 p0 = *(const f32x4*)(ssqkv + (size_t)row * 4);
            const float rstd = 1.0f / sqrtf(((p0[0] + p0[1]) + (p0[2] + p0[3])) * (1.f / KVL) + RMS_EPS);
#pragma unroll
            for (int bj = 0; bj < 2; ++bj) *(u32x4*)(kv + (size_t)row * 2048 + col0 + bj * 128) = pack8(acc[ai][bj][m][0] * rstd, acc[ai][bj][m][1] * rstd); }
    }
};
struct EpiF1 {
    bf16_t* zt;
    __device__ __forceinline__ void operator()(EPI_ARGS) const {
        const int b = u.aux >> 2, g = u.aux & 3;
        store_tile_bf16(acc, u, wr, wc, fr, fq, zt + ((size_t)b * 1024 + g * 256) * 8192 + (size_t)u.orow * SEQ, 8192, 0, u.ocol, 1.f);
    }
};
struct EpiBf16 {
    bf16_t* O; int ldc;
    __device__ __forceinline__ void operator()(EPI_ARGS) const { store_tile_bf16(acc, u, wr, wc, fr, fq, O, ldc, u.orow, u.ocol, 1.f); }
};
struct EpiBranch {
    static constexpr bool CHAIN = true;
    const bf16_t* gates; bf16_t* merged;
    __device__ __forceinline__ bool keep(const Unit& u) const { return u.aux < 2; }
    __device__ __forceinline__ void operator()(EPI_ARGS) const {
        const int br = u.aux, row0 = u.orow + wr * 64 + fr, col0 = u.ocol + wc * 32 + 8 * fq;
        FOR_AI_M { const size_t row = (size_t)(row0 + ai * 128 + m * 16);
#pragma unroll
            for (int bj = 0; bj < 2; ++bj) { const int col = col0 + bj * 128;
                f32x4 g0, g1; unpack8(*(const u32x4*)(gates + row * 6144 + br * 2048 + col), g0, g1);
                if (br < 2) { f32x4 n0, n1; unpack8(*(const u32x4*)(gates + row * 6144 + (br + 1) * 2048 + col), n0, n1);
                    if (br > 0) {
#pragma unroll
                        for (int j = 0; j < 4; ++j) { g0[j] = fmaxf(g0[j], 1e-12f); g1[j] = fmaxf(g1[j], 1e-12f); } }
#pragma unroll
                    for (int j = 0; j < 4; ++j) { g0[j] *= __builtin_amdgcn_rcpf(fmaxf(n0[j], 1e-12f)); g1[j] *= __builtin_amdgcn_rcpf(fmaxf(n1[j], 1e-12f)); }
                    acc[ai][bj][m][0] *= g0; acc[ai][bj][m][1] *= g1;
                } else {
#pragma unroll
                    for (int j = 0; j < 4; ++j) { g0[j] = fmaxf(g0[j], 1e-12f); g1[j] = fmaxf(g1[j], 1e-12f); }
                    *(u32x4*)(merged + row * 2048 + col) = pack8(acc[ai][bj][m][0] * g0, acc[ai][bj][m][1] * g1); } } }
    }
};
struct EpiResid {
    const float* base; float* h;
    __device__ __forceinline__ void operator()(EPI_ARGS) const {
        const int row0 = u.orow + wr * 64 + fr, col0 = u.ocol + wc * 32 + 8 * fq;
        FOR_AI_M { const size_t off = (size_t)(row0 + ai * 128 + m * 16) * 2048 + col0;
#pragma unroll
            for (int bj = 0; bj < 2; ++bj) { const f32x4 b0 = *(const f32x4*)(base + off + bj * 128), b1 = *(const f32x4*)(base + off + bj * 128 + 4);
                *(f32x4*)(h + off + bj * 128) = b0 + acc[ai][bj][m][0]; *(f32x4*)(h + off + bj * 128 + 4) = b1 + acc[ai][bj][m][1]; } }
    }
};
struct EpiSwiglu {
    bf16_t* hm;
    __device__ __forceinline__ void operator()(EPI_ARGS) const {
        const int row0 = u.orow + wr * 64 + fr, col0 = u.ocol + wc * 32 + 8 * fq;
        FOR_AI_M { f32x4 v0, v1;
#pragma unroll
            for (int j = 0; j < 4; ++j) { const float g0 = acc[ai][0][m][0][j], g1 = acc[ai][0][m][1][j];
                v0[j] = g0 * __builtin_amdgcn_rcpf(1.f + __expf(-g0)) * acc[ai][1][m][0][j]; v1[j] = g1 * __builtin_amdgcn_rcpf(1.f + __expf(-g1)) * acc[ai][1][m][1][j]; }
            *(u32x4*)(hm + (size_t)(row0 + ai * 128 + m * 16) * FF + col0) = pack8(v0, v1); }
    }
};
struct EpiDown {
    bf16_t* ye; const float* mgate;
    __device__ __forceinline__ void operator()(EPI_ARGS) const {
        const int row0 = u.orow + wr * 64 + fr, col0 = u.ocol + wc * 32 + 8 * fq;
        FOR_AI_M { const int row = row0 + ai * 128 + m * 16; const float gt = mgate[row];
#pragma unroll
            for (int bj = 0; bj < 2; ++bj) *(u32x4*)(ye + (size_t)row * DM + col0 + bj * 128) = pack8(acc[ai][bj][m][0] * gt, acc[ai][bj][m][1] * gt); }
    }
};

struct Args { const float* in[17]; float* out; unsigned char* ws; int ph_lo, ph_hi; };
enum { I_X = 0, I_WIN, I_BGATE, I_WUQ, I_QNORM, I_WUKV, I_KVNORM, I_RPB, I_WBR, I_WO, I_NMIX, I_NMOE, I_WROUTER, I_WG, I_WU, I_WD, I_NFINAL };
struct Frame { LAS unsigned char* lds; int tid, lane, wave, vcu, G; };

__device__ __forceinline__ int map_col(int map, int n) {
    if (map == 0) return n;
    if (map == 1) {
        if (n < 3072) return n;
        if (n < 3520) return 10240 + (n - 3072);
        if (n < 3680) return 10752 + (n - 3520);
        if (n < 3744) { const int j = n - 3680; return 10912 + (j < 32 ? 2 * j : 2 * (j - 32) + 1); }
        if (n < 4768) return 3072 + (n - 3744);
        return 4096 + (n - 4768);
    }
    const int h = n / 192, c = n - h * 192;
    if (c < 128) return n;
    const int j = c - 128; return h * 192 + 128 + (j < 32 ? 2 * j : 2 * (j - 32) + 1);
}
__device__ __forceinline__ void conv_item(const float* W, int Ksrc, int Nsrc, int ldsrc, bf16_t* Wt, int Kd, const float* gain, int map, int kb, int nb, LAS float* scr, int lane) {
    const int k0 = kb * 64, n0 = nb * 64;
    const int lk = lane >> 4, ln = (lane & 15) * 4;
    f32x4 v[16];
#pragma unroll
    for (int i = 0; i < 16; ++i) { const int k = k0 + 4 * i + lk, n = n0 + ln;
        const bool ok = (k < Ksrc) && (n < Nsrc);
        v[i] = ok ? *(const f32x4*)(W + (size_t)k * ldsrc + n) : (f32x4){0.f, 0.f, 0.f, 0.f};
        if (gain) { const float gg = (k < Ksrc) ? gain[k] : 0.f; v[i] = v[i] * gg; } }
#pragma unroll
    for (int i = 0; i < 16; ++i) { const int kk = 4 * i + lk;
#pragma unroll
        for (int j = 0; j < 4; ++j) scr[(ln + j) * 65 + kk] = v[i][j]; }
    LDS_WAIT(); asm volatile("" ::: "memory");
    const int c = lane & 7;
#pragma unroll
    for (int j = 0; j < 8; ++j) { const int nl = (lane >> 3) + 8 * j, n = n0 + nl;
        const LAS float* s = scr + nl * 65 + 8 * c;
        u32x4 o; o.x = cvt_pk_bf16(s[0], s[1]); o.y = cvt_pk_bf16(s[2], s[3]); o.z = cvt_pk_bf16(s[4], s[5]); o.w = cvt_pk_bf16(s[6], s[7]);
        if (n < Nsrc) *(u32x4*)(Wt + (size_t)map_col(map, n) * Kd + k0 + 8 * c) = o; }
    LDS_WAIT(); asm volatile("" ::: "memory");
}
__device__ __forceinline__ void p_prologue(const Frame& F, const Args& a) {
    LAS float* scr = (LAS float*)(F.lds + F.wave * 16640);
    const int gw = F.vcu * 8 + F.wave, NGW = F.G * 8;
    constexpr int I_IN = 32 * 171, I_UQ = 8 * 24, I_UKV = 4 * 32, I_BR = 3 * 16 * 32, I_O = 32 * 32, I_EXP = 16 * 32 * 32;
    constexpr int I_LAYER = I_IN + I_UQ + I_UKV + I_BR + I_O + 3 * I_EXP;
    for (int it = gw; it < DEPTH * I_LAYER; it += NGW) {
        const int l = it / I_LAYER; int r = it - l * I_LAYER;
        unsigned char* wl = a.ws + WS_W + (size_t)l * W_LAYER;
        if (r < I_IN) { conv_item(a.in[I_WIN] + (size_t)l * DM * IN_COLS, DM, IN_COLS, IN_COLS, (bf16_t*)(wl + WO_IN), DM, nullptr, 1, r / 171, r % 171, scr, F.lane); continue; } r -= I_IN;
        if (r < I_UQ) { conv_item(a.in[I_WUQ] + (size_t)l * QL * 1536, QL, 1536, 1536, (bf16_t*)(wl + WO_UQ), QLP, a.in[I_QNORM] + l * QL, 2, r / 24, r % 24, scr, F.lane); continue; } r -= I_UQ;
        if (r < I_UKV) { conv_item(a.in[I_WUKV] + (size_t)l * KVL * 2048, KVL, 2048, 2048, (bf16_t*)(wl + WO_UKV), KVLP, a.in[I_KVNORM] + l * KVL, 0, r / 32, r % 32, scr, F.lane); continue; } r -= I_UKV;
        if (r < I_BR) { const int br = r / 512, q = r % 512; conv_item(a.in[I_WBR] + ((size_t)l * 3 + br) * 1024 * DM, 1024, DM, DM, (bf16_t*)(wl + WO_BR) + (size_t)br * DM * 1024, 1024, nullptr, 0, q / 32, q % 32, scr, F.lane); continue; } r -= I_BR;
        if (r < I_O) { conv_item(a.in[I_WO] + (size_t)l * DM * DM, DM, DM, DM, (bf16_t*)(wl + WO_O), DM, nullptr, 0, r / 32, r % 32, scr, F.lane); continue; } r -= I_O;
        if (r < I_EXP) { const int e = r / 1024, q = r % 1024; conv_item(a.in[I_WG] + ((size_t)l * NE + e) * DM * FF, DM, FF, FF, (bf16_t*)(wl + WO_GU) + (size_t)e * 2 * FF * DM, DM, nullptr, 0, q / 32, q % 32, scr, F.lane); continue; } r -= I_EXP;
        if (r < I_EXP) { const int e = r / 1024, q = r % 1024; conv_item(a.in[I_WU] + ((size_t)l * NE + e) * DM * FF, DM, FF, FF, (bf16_t*)(wl + WO_GU) + ((size_t)e * 2 + 1) * FF * DM, DM, nullptr, 0, q / 32, q % 32, scr, F.lane); continue; } r -= I_EXP;
        { const int e = r / 1024, q = r % 1024; conv_item(a.in[I_WD] + ((size_t)l * NE + e) * FF * DM, FF, DM, DM, (bf16_t*)(wl + WO_D) + (size_t)e * DM * FF, FF, nullptr, 0, q / 32, q % 32, scr, F.lane); }
    }
    const int gt = F.vcu * 512 + F.tid, NGT = F.G * 512;
    for (int i = gt; i < DEPTH * 96 * 256; i += NGT) { const int l = i / (96 * 256), q = i % (96 * 256), rr = q >> 8, ch = q & 255;
        const int row = rr < 64 ? 10688 + rr : 10976 + (rr - 64);
        *(u32x4*)((bf16_t*)(a.ws + WS_W + (size_t)l * W_LAYER + WO_IN) + (size_t)row * DM + ch * 8) = (u32x4){0u, 0u, 0u, 0u}; }
    for (int i = gt; i < SEQ * 32; i += NGT) { const int s = i >> 5, j = i & 31;
        const float inv = 1.0f / powf(10000.0f, (float)(2 * j) / 64.0f); const float ang = (float)s * inv;
        ((float*)(a.ws + WS_ROPEC))[i] = cosf(ang); ((float*)(a.ws + WS_ROPES))[i] = sinf(ang); }
    for (int i = gt; i < 512 * 256; i += NGT) { const int r = i >> 8, j = i & 255, c = r & 255; const int m = (c * j) & 255;
        float sn, cs; sincospif((float)m * (1.0f / 128.0f), &sn, &cs);
        ((bf16_t*)(a.ws + WS_WCH))[i] = (bf16_t)f2bf((r < 256 ? cs : sn) * 0.0625f); }
    for (int i = gt; i < 4096 * 1024; i += NGT) { const int k = i >> 10, n8 = (i & 1023) * 8; float o[8];
#pragma unroll
        for (int j = 0; j < 8; ++j) { const int np = n8 + j, n = np & 4095, m = (k * n) & 4095; float sn, cs; sincospif((float)m * (1.0f / 2048.0f), &sn, &cs); o[j] = (np < 4096 ? cs : -sn) * 0.015625f; }
        u32x4 w; w.x = cvt_pk_bf16(o[0], o[1]); w.y = cvt_pk_bf16(o[2], o[3]); w.z = cvt_pk_bf16(o[4], o[5]); w.w = cvt_pk_bf16(o[6], o[7]);
        *(u32x4*)((bf16_t*)(a.ws + WS_ADFT) + (size_t)k * 8192 + n8) = w; }
}
__device__ __forceinline__ void rms_row(const float* xrow, const float* gain, bf16_t* orow, int lane) {
    const f32x4* xr = (const f32x4*)xrow + lane; f32x4 v[8]; float s = 0.f;
#pragma unroll
    for (int j = 0; j < 8; ++j) { v[j] = xr[64 * j]; s += (v[j][0] * v[j][0] + v[j][1] * v[j][1]) + (v[j][2] * v[j][2] + v[j][3] * v[j][3]); }
    const float rstd = 1.0f / sqrtf(wave_sum(s) * (1.f / DM) + RMS_EPS);
#pragma unroll
    for (int j = 0; j < 8; ++j) { const f32x4 g = ((const f32x4*)gain)[lane + 64 * j]; const f32x4 y = v[j] * rstd * g;
        u32x2 w; w.x = cvt_pk_bf16(y[0], y[1]); w.y = cvt_pk_bf16(y[2], y[3]); ((u32x2*)orow)[lane + 64 * j] = w; }
}

constexpr int NA_K_BYTES = 15 * 32 * 128, NA_V_OFF = NA_K_BYTES, NA_RPB_OFF = 2 * NA_K_BYTES;
__device__ __forceinline__ void na_unit(const bf16_t* Q, const LAS unsigned char* lds, bf16_t* Y, int b, int h, int r, int jb, int row0, int lane) {
    const int qi = lane & 15, qd = lane >> 4;
    const int rs = min(max(r - 4, 0), 56), lr0 = rs - row0;
    const int colstart = min(max(16 * jb - 8, 0), 32);
    const int qc = 16 * jb + qi, cs = min(max(qc - 8, 0), 48);
    const int tb = b * SEQ;
    const LAS float* rpb2 = (const LAS float*)(lds + NA_RPB_OFF);
    const bf16_t* qp = Q + (size_t)(tb + r * 64 + qc) * 1024 + h * 64 + qd * 8;
    const bf16x8 bq0 = *(const bf16x8*)qp, bq1 = *(const bf16x8*)(qp + 32);
    f32x4 s[16];
    const int kx = (qi >> 1) & 7;
#pragma unroll
    for (int kr = 0; kr < 8; ++kr)
#pragma unroll
        for (int kb = 0; kb < 2; ++kb) {
            const LAS unsigned char* kp = lds + ((lr0 + kr) * 32 + 16 * kb + qi) * 128;
            const bf16x8 a0 = *(const LAS bf16x8*)(kp + ((qd ^ kx) << 4)), a1 = *(const LAS bf16x8*)(kp + (((4 + qd) ^ kx) << 4));
            f32x4 z = (f32x4){0.f, 0.f, 0.f, 0.f};
            z = __builtin_amdgcn_mfma_f32_16x16x32_bf16(a0, bq0, z, 0, 0, 0);
            z = __builtin_amdgcn_mfma_f32_16x16x32_bf16(a1, bq1, z, 0, 0, 0);
            s[kr * 2 + kb] = z;
        }
    float mx = -3.0e38f;
#pragma unroll
    for (int kr = 0; kr < 8; ++kr) { const LAS float* brow = rpb2 + (rs + kr - r + 7) * 31;
#pragma unroll
        for (int kb = 0; kb < 2; ++kb)
#pragma unroll
            for (int i = 0; i < 4; ++i) { const int kc = colstart + 16 * kb + 4 * qd + i; const bool valid = (kc >= cs) && (kc < cs + 16);
                const int dc = min(max(kc - qc + 15, 0), 30);
                const float v = valid ? fmaf(s[kr * 2 + kb][i], LOG2E, brow[dc]) : -1.0e30f;
                s[kr * 2 + kb][i] = v; mx = fmaxf(mx, v); } }
    mx = fmaxf(mx, __shfl_xor(mx, 16)); mx = fmaxf(mx, __shfl_xor(mx, 32));
    float sum = 0.f;
#pragma unroll
    for (int t = 0; t < 16; ++t)
#pragma unroll
        for (int i = 0; i < 4; ++i) { const float p = __builtin_amdgcn_exp2f(s[t][i] - mx); s[t][i] = p; sum += p; }
    sum += __shfl_xor(sum, 16); sum += __shfl_xor(sum, 32);
    const float rinv = 1.0f / sum;
    f32x4 o[4];
#pragma unroll
    for (int db = 0; db < 4; ++db) o[db] = (f32x4){0.f, 0.f, 0.f, 0.f};
    const int vx = (qi >> 2) & 3;
    const int vlo = (((qd >> 1) ^ vx) << 4) + ((qd & 1) << 3), vhi = (((2 + (qd >> 1)) ^ vx) << 4) + ((qd & 1) << 3);
#pragma unroll
    for (int kr = 0; kr < 8; ++kr) {
        u32x4 pw; pw.x = cvt_pk_bf16(s[kr * 2][0], s[kr * 2][1]); pw.y = cvt_pk_bf16(s[kr * 2][2], s[kr * 2][3]); pw.z = cvt_pk_bf16(s[kr * 2 + 1][0], s[kr * 2 + 1][1]); pw.w = cvt_pk_bf16(s[kr * 2 + 1][2], s[kr * 2 + 1][3]);
        const bf16x8 pf = *reinterpret_cast<const bf16x8*>(&pw);
#pragma unroll
        for (int db = 0; db < 4; ++db) { const LAS unsigned char* vp = lds + NA_V_OFF + ((lr0 + kr) * 64 + 16 * db + qi) * 64;
            const u32x2 lo = *(const LAS u32x2*)(vp + vlo), hi = *(const LAS u32x2*)(vp + vhi);
            u32x4 vw; vw.x = lo.x; vw.y = lo.y; vw.z = hi.x; vw.w = hi.y;
            o[db] = __builtin_amdgcn_mfma_f32_16x16x32_bf16(*reinterpret_cast<const bf16x8*>(&vw), pf, o[db], 0, 0, 0); } }
    bf16_t* yp = Y + (size_t)(tb + r * 64 + qc) * 1024 + h * 64 + 4 * qd;
#pragma unroll
    for (int db = 0; db < 4; ++db) { u32x2 w; w.x = cvt_pk_bf16(o[db][0] * rinv, o[db][1] * rinv); w.y = cvt_pk_bf16(o[db][2] * rinv, o[db][3] * rinv); *(u32x2*)(yp + 16 * db) = w; }
}
__device__ __forceinline__ void na_phase(const Frame& F, const float* rpb, const bf16_t* Q, const bf16_t* K, const bf16_t* Vt, bf16_t* Y) {
    for (int uidx = F.vcu; uidx < 2048; uidx += F.G) {
        const int rblk = uidx & 7, jb = (uidx >> 3) & 3, h = (uidx >> 5) & 15, b = uidx >> 9;
        const int row0 = min(max(8 * rblk - 4, 0), 56), colstart = min(max(16 * jb - 8, 0), 32);
#pragma unroll 1
        for (int inst = F.wave; inst < 60; inst += 8) { const int key = 8 * inst + (F.lane >> 3), pc = F.lane & 7, c = pc ^ ((key >> 1) & 7);
            const int krow = min(row0 + (key >> 5), 63), kcol = colstart + (key & 31);
            __builtin_amdgcn_global_load_lds((const unsigned*)(K + (size_t)(b * SEQ + krow * 64 + kcol) * 1024 + h * 64 + c * 8), (LAS unsigned*)(F.lds + inst * 1024), 16, 0, 0); }
#pragma unroll 1
        for (int inst = F.wave; inst < 60; inst += 8) { const int piece = 16 * inst + (F.lane >> 2), pc = F.lane & 3, d = piece & 63, kr = piece >> 6, c = pc ^ ((d >> 2) & 3);
            const int krow = min(row0 + kr, 63);
            __builtin_amdgcn_global_load_lds((const unsigned*)(Vt + ((size_t)(b * 16 + h) * 64 + d) * SEQ + krow * 64 + colstart + c * 8), (LAS unsigned*)(F.lds + NA_V_OFF + inst * 1024), 16, 0, 0); }
        for (int i = F.tid; i < 15 * 31; i += 512) ((LAS float*)(F.lds + NA_RPB_OFF))[i] = rpb[h * 465 + i] * LOG2E;
        asm volatile("s_waitcnt vmcnt(0)" ::: "memory");
        __syncthreads();
        na_unit(Q, F.lds, Y, b, h, rblk * 8 + F.wave, jb, row0, F.lane);
        __syncthreads();
    }
}
namespace mla {
constexpr int D = 128, NW = 8, QBLK = 32, KVBLK = 64;
constexpr float SCALE = 0.07216878364870322f;
constexpr float THR = 8.f;
constexpr int SDEPTH = 1;
constexpr int LDQ = 1536, LDK = 2048, LDP = 64;
constexpr int SHM_V = KVBLK * D * 2, SHM_K = KVBLK * D * 2, SHM_P = KVBLK * 64 * 2;
constexpr int OFF_V = 0, OFF_K = 2 * SHM_V, OFF_P = OFF_K + 2 * SHM_K, OFF_WS = OFF_P + 2 * SHM_P, SHM_ATTN = OFF_WS + NW * 64 * 4;
#define KSWZ(row, colB) ((row) * 256 + ((colB) ^ (((row) & 7) << 4)))
#define PSWZ(row, colB) ((row) * 128 + ((colB) ^ ((((row) >> 1) & 7) << 4)))
#define SBAR() __builtin_amdgcn_sched_barrier(0)
__device__ __forceinline__ int crow(int r, int hi) { return (r & 3) + 8 * (r >> 2) + 4 * hi; }
__device__ __forceinline__ void partialSM(f32x16& p0, f32x16& p1, float& m_reg, float& mn, float& alpha) {
  constexpr float C = SCALE * 1.4426950408889634f;
  float pmax = p0[0];
#pragma unroll
  for (int r = 1; r < 16; ++r) pmax = fmaxf(pmax, p0[r]);
#pragma unroll
  for (int r = 0; r < 16; ++r) pmax = fmaxf(pmax, p1[r]);
  { auto rr = __builtin_amdgcn_permlane32_swap(__float_as_uint(pmax), __float_as_uint(pmax), false, false);
    pmax = fmaxf(__uint_as_float(rr[0]), __uint_as_float(rr[1])); }
  if (__builtin_expect(__all(pmax - m_reg <= THR / SCALE), 1)) { mn = m_reg; alpha = 1.f; }
  else { mn = fmaxf(m_reg, pmax); alpha = __builtin_amdgcn_exp2f((m_reg - mn) * C); m_reg = mn; }
  float mnC = -mn * C;
#pragma unroll
  for (int r = 0; r < 16; ++r) p0[r] = fmaf(p0[r], C, mnC);
#pragma unroll
  for (int r = 0; r < 16; ++r) p1[r] = fmaf(p1[r], C, mnC);
#pragma unroll
  for (int r = 0; r < 16; ++r) p0[r] = __builtin_amdgcn_exp2f(p0[r]);
}
__device__ __forceinline__ void finishSM(f32x16& p0, f32x16& p1, float alpha, float& l_reg, bf16x8& pa0, bf16x8& pa1, bf16x8& pa2, bf16x8& pa3) {
#pragma unroll
  for (int r = 0; r < 16; ++r) p1[r] = __builtin_amdgcn_exp2f(p1[r]);
  float ps = 0;
#pragma unroll
  for (int r = 0; r < 16; ++r) ps += p0[r];
#pragma unroll
  for (int r = 0; r < 16; ++r) ps += p1[r];
  { auto rr = __builtin_amdgcn_permlane32_swap(__float_as_uint(ps), __float_as_uint(ps), false, false);
    ps = __uint_as_float(rr[0]) + __uint_as_float(rr[1]); }
  l_reg = l_reg * alpha + ps;
#define PK4(P, BASE, OUT) do { unsigned a0 = cvt_pk_bf16(P[BASE + 0], P[BASE + 1]), a1 = cvt_pk_bf16(P[BASE + 2], P[BASE + 3]);   \
    unsigned b0 = cvt_pk_bf16(P[BASE + 4], P[BASE + 5]), b1 = cvt_pk_bf16(P[BASE + 6], P[BASE + 7]);                              \
    auto r0 = __builtin_amdgcn_permlane32_swap(a0, b0, false, false); auto r1 = __builtin_amdgcn_permlane32_swap(a1, b1, false, false); \
    u32x4 w = {r0[0], r1[0], r0[1], r1[1]}; OUT = *reinterpret_cast<bf16x8*>(&w); } while (0)
  PK4(p0, 0, pa0); PK4(p0, 8, pa1); PK4(p1, 0, pa2); PK4(p1, 8, pa3);
#undef PK4
}
__device__ __forceinline__ void qkt(f32x16& p0, f32x16& p1, const char* Ks, const char* Ps, const bf16x8* qr, int r32, int hi) {
  p0 = f32x16{}; p1 = f32x16{};
#pragma unroll
  for (int d0 = 0; d0 < 8; ++d0) { int cb = (d0 * 16 + hi * 8) * 2;
    bf16x8 b0 = *reinterpret_cast<const bf16x8*>(Ks + KSWZ(r32, cb));
    bf16x8 b1 = *reinterpret_cast<const bf16x8*>(Ks + KSWZ(32 + r32, cb));
    p0 = __builtin_amdgcn_mfma_f32_32x32x16_bf16(b0, qr[d0], p0, 0, 0, 0);
    p1 = __builtin_amdgcn_mfma_f32_32x32x16_bf16(b1, qr[d0], p1, 0, 0, 0); }
#pragma unroll
  for (int d0 = 0; d0 < 4; ++d0) { int cb = (d0 * 16 + hi * 8) * 2;
    bf16x8 b0 = *reinterpret_cast<const bf16x8*>(Ps + PSWZ(r32, cb));
    bf16x8 b1 = *reinterpret_cast<const bf16x8*>(Ps + PSWZ(32 + r32, cb));
    p0 = __builtin_amdgcn_mfma_f32_32x32x16_bf16(b0, qr[8 + d0], p0, 0, 0, 0);
    p1 = __builtin_amdgcn_mfma_f32_32x32x16_bf16(b1, qr[8 + d0], p1, 0, 0, 0); }
}
__device__ __forceinline__ int v_st(int k, int c) { const int kk = (k & ~0xC) | ((k & 4) << 1) | ((k & 8) >> 1); return ((kk >> 3) * 4 + (c >> 5)) * 512 + ((kk & 7) * 32 + (c & 31)) * 2; }
__device__ __forceinline__ int v_rd_base(int lane) { return ((lane & 3) << 3) | (((lane >> 2) & 3) << 6) | (((lane >> 4) & 1) << 5) | (((lane >> 5) & 1) << 8); }
constexpr int v_rd_off(int d0, int ks, int half) { return d0 * 512 + ks * 4096 + half * 2048; }
template <int OFF> __device__ __forceinline__ s16x4 tr_read(int vb) {
  s16x4 r; asm volatile("ds_read_b64_tr_b16 %0, %1 offset:%2" : "=&v"(r) : "v"(vb), "i"(OFF) : "memory"); return r;
}
template <int D0> __device__ __forceinline__ void pv_one(f32x16& od, int vb, bf16x8 pa0, bf16x8 pa1, bf16x8 pa2, bf16x8 pa3) {
  const s16x4 l0 = tr_read<v_rd_off(D0, 0, 0)>(vb), h0 = tr_read<v_rd_off(D0, 0, 1)>(vb), l1 = tr_read<v_rd_off(D0, 1, 0)>(vb), h1 = tr_read<v_rd_off(D0, 1, 1)>(vb);
  const s16x4 l2 = tr_read<v_rd_off(D0, 2, 0)>(vb), h2 = tr_read<v_rd_off(D0, 2, 1)>(vb), l3 = tr_read<v_rd_off(D0, 3, 0)>(vb), h3 = tr_read<v_rd_off(D0, 3, 1)>(vb);
  asm volatile("s_waitcnt lgkmcnt(0)" ::: "memory"); SBAR();
#define PK(L, H) (bf16x8){L[0], L[1], L[2], L[3], H[0], H[1], H[2], H[3]}
  od = __builtin_amdgcn_mfma_f32_32x32x16_bf16(pa0, PK(l0, h0), od, 0, 0, 0);
  od = __builtin_amdgcn_mfma_f32_32x32x16_bf16(pa1, PK(l1, h1), od, 0, 0, 0);
  od = __builtin_amdgcn_mfma_f32_32x32x16_bf16(pa2, PK(l2, h2), od, 0, 0, 0);
  od = __builtin_amdgcn_mfma_f32_32x32x16_bf16(pa3, PK(l3, h3), od, 0, 0, 0);
#undef PK
}
__device__ __forceinline__ void pv_d0(f32x16* o, int vb, bf16x8 pa0, bf16x8 pa1, bf16x8 pa2, bf16x8 pa3) {
  pv_one<0>(o[0], vb, pa0, pa1, pa2, pa3); pv_one<1>(o[1], vb, pa0, pa1, pa2, pa3); pv_one<2>(o[2], vb, pa0, pa1, pa2, pa3); pv_one<3>(o[3], vb, pa0, pa1, pa2, pa3);
}
__device__ __forceinline__ void attn_body(const bf16_t* __restrict__ Qb, const bf16_t* __restrict__ Kh, const bf16_t* __restrict__ Vh, const bf16_t* __restrict__ Ph,
                                          bf16_t* __restrict__ Ob, int seq, char* lds) {
  int tid_ = threadIdx.x; asm volatile("" : "+v"(tid_));
  const int tid = tid_, wid = tid >> 6, lane = tid & 63, r32 = lane & 31, hi = lane >> 5;
  char* V_lds = lds + OFF_V; char* K_lds = lds + OFF_K; char* P_lds = lds + OFF_P;
  float* ws = (float*)(lds + OFF_WS) + wid * 64; float* li_l = ws; float* al_l = ws + 32;
  float m_reg = -1e30f, l_reg = 0; f32x16 o[4] = {}; bf16x8 qr[12];
  const bf16_t* Qw = Qb + (long)(wid * QBLK + r32) * LDQ + hi * 8;
#pragma unroll
  for (int d0 = 0; d0 < 12; ++d0) qr[d0] = *reinterpret_cast<const bf16x8*>(Qw + d0 * 16);
  const int sr = tid >> 4, sc = (tid & 15) * 8, vst0 = v_st(sr, sc), vst1 = v_st(32 + sr, sc);
  const int pr = tid >> 3, pc = (tid & 7) * 8;
  const int vb0 = (int)(uintptr_t)V_lds + v_rd_base(lane);
  struct { bf16x8 vs0, vs1, ks0, ks1, ps; } sr_[SDEPTH];
#define SLOAD(i, k0) do { sr_[i].vs0 = *reinterpret_cast<const bf16x8*>(&Vh[(long)((k0) + sr) * LDK + sc]); sr_[i].vs1 = *reinterpret_cast<const bf16x8*>(&Vh[(long)((k0) + 32 + sr) * LDK + sc]); \
    sr_[i].ks0 = *reinterpret_cast<const bf16x8*>(&Kh[(long)((k0) + sr) * LDK + sc]); sr_[i].ks1 = *reinterpret_cast<const bf16x8*>(&Kh[(long)((k0) + 32 + sr) * LDK + sc]); \
    sr_[i].ps = *reinterpret_cast<const bf16x8*>(&Ph[(long)((k0) + pr) * LDP + pc]); } while (0)
#define SWRITE(b, i) do { *(bf16x8*)(V_lds + (b) * SHM_V + vst0) = sr_[i].vs0; *(bf16x8*)(V_lds + (b) * SHM_V + vst1) = sr_[i].vs1; int kc = sc * 2; \
    *(bf16x8*)(K_lds + (b) * SHM_K + KSWZ(sr, kc)) = sr_[i].ks0; *(bf16x8*)(K_lds + (b) * SHM_K + KSWZ(32 + sr, kc)) = sr_[i].ks1; \
    *(bf16x8*)(P_lds + (b) * SHM_P + PSWZ(pr, pc * 2)) = sr_[i].ps; } while (0)
#define SWAIT() do { if constexpr (SDEPTH == 2) asm volatile("s_waitcnt vmcnt(5)" ::: "memory"); else asm volatile("s_waitcnt vmcnt(0)" ::: "memory"); } while (0)
#define RESC(a) do { if (__any((a) < 1.f)) { if (hi == 0) al_l[r32] = (a); asm volatile("s_waitcnt lgkmcnt(0)" ::: "memory"); \
    _Pragma("unroll") for (int d = 0; d < 4; ++d) _Pragma("unroll") for (int r = 0; r < 16; ++r) o[d][r] *= al_l[crow(r, hi)]; } } while (0)
  f32x16 pA0, pA1, pB0, pB1; float mnA, mnB, alA, alB; bf16x8 pa0, pa1, pa2, pa3; const int NT = seq / KVBLK;
  constexpr int SE = 0, SO = SDEPTH - 1;
  SLOAD(SE, 0); asm volatile("s_waitcnt vmcnt(0)" ::: "memory"); SWRITE(0, SE); __syncthreads();
  qkt(pA0, pA1, K_lds, P_lds, qr, r32, hi); partialSM(pA0, pA1, m_reg, mnA, alA);
  SLOAD(SO, KVBLK); if constexpr (SDEPTH == 2) { if (2 < NT) SLOAD(SE, 2 * KVBLK); }
  SWAIT(); SWRITE(1, SO); __syncthreads();
  for (int j = 1; j + 1 < NT; j += 2) {
    SBAR(); qkt(pB0, pB1, K_lds + SHM_K, P_lds + SHM_P, qr, r32, hi);
    finishSM(pA0, pA1, alA, l_reg, pa0, pa1, pa2, pa3); SBAR();
    SLOAD(SO, (j + SDEPTH) * KVBLK); SBAR();
    pv_d0(o, vb0, pa0, pa1, pa2, pa3); partialSM(pB0, pB1, m_reg, mnB, alB);
    __syncthreads(); SWAIT(); SWRITE(0, SE);
    RESC(alB); __syncthreads();
    SBAR(); qkt(pA0, pA1, K_lds, P_lds, qr, r32, hi);
    finishSM(pB0, pB1, alB, l_reg, pa0, pa1, pa2, pa3); SBAR();
    if (SDEPTH == 1 || j + 3 < NT) SLOAD(SE, (j + 1 + SDEPTH) * KVBLK); SBAR();
    pv_d0(o, vb0 + (int)SHM_V, pa0, pa1, pa2, pa3); partialSM(pA0, pA1, m_reg, mnA, alA);
    __syncthreads(); SWAIT(); SWRITE(1, SO);
    RESC(alA); __syncthreads();
  }
  SBAR(); qkt(pB0, pB1, K_lds + SHM_K, P_lds + SHM_P, qr, r32, hi);
  finishSM(pA0, pA1, alA, l_reg, pa0, pa1, pa2, pa3); SBAR();
  pv_d0(o, vb0, pa0, pa1, pa2, pa3); partialSM(pB0, pB1, m_reg, mnB, alB);
  __syncthreads(); RESC(alB);
  finishSM(pB0, pB1, alB, l_reg, pa0, pa1, pa2, pa3); SBAR();
  pv_d0(o, vb0 + (int)SHM_V, pa0, pa1, pa2, pa3);
  if (hi == 0) li_l[r32] = l_reg; asm volatile("s_waitcnt lgkmcnt(0)" ::: "memory");
  float rli[16];
#pragma unroll
  for (int r = 0; r < 16; ++r) rli[r] = __builtin_amdgcn_rcpf(li_l[crow(r, hi)]);
  bf16_t* Ow = Ob + (long)(wid * QBLK) * 1024;
#pragma unroll
  for (int r = 0; r < 16; ++r) { int orow = crow(r, hi);
#pragma unroll
    for (int d0 = 0; d0 < 4; ++d0) Ow[(long)orow * 1024 + d0 * 32 + r32] = (bf16_t)f2bf(o[d0][r] * rli[r]); }
  __syncthreads();
#undef SLOAD
#undef SWRITE
#undef SWAIT
#undef RESC
}
}

__device__ __forceinline__ void router_phase(const Frame& F, const float* h, const float* gain, const float* wr, bf16_t* xn, float* aff) {
    LAS float* wt = (LAS float*)F.lds;
    for (int i = F.tid; i < DM * NE; i += 512) { const int k = i >> 4, e = i & 15; wt[e * DM + k] = wr[i]; }
    __syncthreads();
    const int gw = F.vcu * 8 + F.wave, NGW = F.G * 8;
    for (int t = gw; t < T; t += NGW) {
        const f32x4* xr = (const f32x4*)(h + (size_t)t * DM) + F.lane; f32x4 v[8]; float s = 0.f;
#pragma unroll
        for (int j = 0; j < 8; ++j) { v[j] = xr[64 * j]; s += (v[j][0] * v[j][0] + v[j][1] * v[j][1]) + (v[j][2] * v[j][2] + v[j][3] * v[j][3]); }
        const float rstd = 1.0f / sqrtf(wave_sum(s) * (1.f / DM) + RMS_EPS);
#pragma unroll
        for (int j = 0; j < 8; ++j) { const f32x4 g = ((const f32x4*)gain)[F.lane + 64 * j]; v[j] = v[j] * rstd * g;
            u32x2 w; w.x = cvt_pk_bf16(v[j][0], v[j][1]); w.y = cvt_pk_bf16(v[j][2], v[j][3]); ((u32x2*)(xn + (size_t)t * DM))[F.lane + 64 * j] = w; }
        float lg[16];
#pragma unroll
        for (int e = 0; e < 16; ++e) { float a = 0.f;
#pragma unroll
            for (int j = 0; j < 8; ++j) { const f32x4 w = *(const LAS f32x4*)(wt + e * DM + 4 * F.lane + 256 * j); a += (v[j][0] * w[0] + v[j][1] * w[1]) + (v[j][2] * w[2] + v[j][3] * w[3]); }
            lg[e] = wave_sum(a); }
        float mx = lg[0];
#pragma unroll
        for (int e = 1; e < 16; ++e) mx = fmaxf(mx, lg[e]);
        float sum = 0.f;
#pragma unroll
        for (int e = 0; e < 16; ++e) { lg[e] = __expf(lg[e] - mx); sum += lg[e]; }
        const float rs = 1.0f / sum; float mine = 0.f;
#pragma unroll
        for (int e = 0; e < 16; ++e) mine = (F.lane == e) ? lg[e] * rs : mine;
        if (F.lane < 16) aff[((size_t)(t >> 12) * NE + F.lane) * SEQ + (t & 4095)] = mine;
    }
    __syncthreads();
}
__device__ __forceinline__ void topk_unit(const Frame& F, const float* aff, int b, int e, int* mrows, float* mgate, int* slot_of) {
    LAS int* hist = (LAS int*)F.lds; LAS int* misc = hist + 256; LAS int* wtot = hist + 272;
    const float* ap = aff + ((size_t)b * NE + e) * SEQ + F.tid * 8;
    const f32x4 x0 = *(const f32x4*)ap, x1 = *(const f32x4*)(ap + 4);
    unsigned uu[8];
#pragma unroll
    for (int i = 0; i < 4; ++i) { uu[i] = __float_as_uint(x0[i]); uu[4 + i] = __float_as_uint(x1[i]); }
    unsigned prefix = 0; int kth = CAP;
#pragma unroll 1
    for (int pass = 0; pass < 4; ++pass) {
        const int shift = 24 - 8 * pass;
        if (F.tid < 256) hist[F.tid] = 0;
        __syncthreads();
#pragma unroll
        for (int i = 0; i < 8; ++i) { const bool in = (pass == 0) || ((uu[i] >> (shift + 8)) == (prefix >> (shift + 8)));
            if (in) atomicAdd((int*)&hist[(uu[i] >> shift) & 255], 1); }
        __syncthreads();
        if (F.wave == 0) {
            const int c0 = hist[4 * F.lane], c1 = hist[4 * F.lane + 1], c2 = hist[4 * F.lane + 2], c3 = hist[4 * F.lane + 3];
            const int tot = c0 + c1 + c2 + c3; int x = tot;
#pragma unroll
            for (int o = 1; o < 64; o <<= 1) { const int y = __shfl_down(x, o); if (F.lane + o < 64) x += y; }
            const int above = x - tot;
            if (above < kth && kth <= above + tot) {
                int a = above, bin, nk;
                if (kth <= a + c3) { bin = 3; nk = kth - a; }
                else { a += c3; if (kth <= a + c2) { bin = 2; nk = kth - a; }
                else { a += c2; if (kth <= a + c1) { bin = 1; nk = kth - a; }
                else { a += c1; bin = 0; nk = kth - a; } } }
                misc[0] = 4 * F.lane + bin; misc[1] = nk;
            }
        }
        __syncthreads();
        prefix |= ((unsigned)misc[0]) << shift; kth = misc[1];
        __syncthreads();
    }
    int cg = 0, ce = 0;
#pragma unroll
    for (int i = 0; i < 8; ++i) { cg += (uu[i] > prefix) ? 1 : 0; ce += (uu[i] == prefix) ? 1 : 0; }
    int pk = cg | (ce << 16), inc = pk;
#pragma unroll
    for (int o = 1; o < 64; o <<= 1) { const int y = __shfl_up(inc, o); if (F.lane >= o) inc += y; }
    if (F.lane == 63) wtot[F.wave] = inc;
    __syncthreads();
    int base = 0;
#pragma unroll
    for (int w = 0; w < 8; ++w) base += (w < F.wave) ? wtot[w] : 0;
    int excl = base + inc - pk; int gb = excl & 0xffff, eb = excl >> 16;
#pragma unroll
    for (int i = 0; i < 8; ++i) { const int s = F.tid * 8 + i; const bool g = uu[i] > prefix, q = uu[i] == prefix;
        const bool sel = g || (q && eb < kth);
        const int slot = gb + min(eb, kth);
        if (sel) { mrows[e * ROWS_E + b * CAP + slot] = b * SEQ + s; mgate[e * ROWS_E + b * CAP + slot] = __uint_as_float(uu[i]); }
        slot_of[(size_t)(b * SEQ + s) * NE + e] = sel ? (b * CAP + slot) : -1;
        gb += g ? 1 : 0; eb += q ? 1 : 0; }
    __syncthreads();
}
__device__ __forceinline__ void combine_phase(const Frame& F, float* h, const bf16_t* ye, const int* slot_of, const float* gain, bf16_t* xn_next, float* out_final) {
    const int gw = F.vcu * 8 + F.wave, NGW = F.G * 8;
    for (int t = gw; t < T; t += NGW) {
        f32x4* hr = (f32x4*)(h + (size_t)t * DM) + F.lane; f32x4 v[8];
#pragma unroll
        for (int j = 0; j < 8; ++j) v[j] = hr[64 * j];
        const int so = slot_of[(size_t)t * NE + (F.lane & 15)];
        unsigned long long mask = __ballot(F.lane < 16 && so >= 0);
        while (mask) { const int e = __builtin_amdgcn_readfirstlane((int)__builtin_ctzll(mask)); mask &= mask - 1;
            const int slot = __builtin_amdgcn_readlane(so, e);
            const u32x2* yr = (const u32x2*)(ye + ((size_t)e * ROWS_E + slot) * DM) + F.lane;
#pragma unroll
            for (int j = 0; j < 8; ++j) { const u32x2 w = yr[64 * j];
                v[j][0] += __uint_as_float(w.x << 16); v[j][1] += __uint_as_float(w.x & 0xffff0000u); v[j][2] += __uint_as_float(w.y << 16); v[j][3] += __uint_as_float(w.y & 0xffff0000u); } }
        float s = 0.f;
#pragma unroll
        for (int j = 0; j < 8; ++j) s += (v[j][0] * v[j][0] + v[j][1] * v[j][1]) + (v[j][2] * v[j][2] + v[j][3] * v[j][3]);
        const float rstd = 1.0f / sqrtf(wave_sum(s) * (1.f / DM) + RMS_EPS);
        if (xn_next) {
#pragma unroll
            for (int j = 0; j < 8; ++j) { hr[64 * j] = v[j]; const f32x4 g = ((const f32x4*)gain)[F.lane + 64 * j]; const f32x4 y = v[j] * rstd * g;
                u32x2 w; w.x = cvt_pk_bf16(y[0], y[1]); w.y = cvt_pk_bf16(y[2], y[3]); ((u32x2*)(xn_next + (size_t)t * DM))[F.lane + 64 * j] = w; }
        } else {
#pragma unroll
            for (int j = 0; j < 8; ++j) { if (MK_DEBUG) hr[64 * j] = v[j]; const f32x4 g = ((const f32x4*)gain)[F.lane + 64 * j]; ((f32x4*)(out_final + (size_t)t * DM))[F.lane + 64 * j] = v[j] * rstd * g; }
        }
    }
}

#ifndef PROBE_DUP
#define PROBE_DUP -1
#endif
#define DUP(k) _Pragma("unroll 1") for (int rep_ = 0; rep_ < ((PROBE_DUP == (k)) ? 2 : 1); ++rep_)
#ifndef PHMASK
#define PHMASK 0xFFFFF
#endif
#define EN(b) if constexpr ((PHMASK >> (b)) & 1)
constexpr int N_PHASES = 1 + 10 * DEPTH;
__device__ __forceinline__ bool in_range(int lo, int hi, int k) { asm volatile("" : "+s"(lo), "+s"(hi)); return lo <= k && k < hi; }
__global__ void __launch_bounds__(512, 2) fwd(Args a) {
    extern __shared__ __attribute__((aligned(16))) unsigned char lds[];
    Frame F;
    F.lds = (LAS unsigned char*)lds;
    F.tid = threadIdx.x; F.lane = F.tid & 63; F.wave = __builtin_amdgcn_readfirstlane(F.tid >> 6);
    F.G = gridDim.x; { const int bx = blockIdx.x; F.vcu = (F.G % 8 == 0) ? (bx % 8) * (F.G / 8) + bx / 8 : bx; }
    volatile LAS unsigned* MISC = (volatile LAS unsigned*)(F.lds + MISC_OFF);
    if (F.tid < 64) MISC[F.tid] = 0u;
    __syncthreads();
    const int lo = a.ph_lo, hi = a.ph_hi;
    XcdBarrier bar; bar.bar = (unsigned*)(a.ws + WS_CTL); bar.x = 0; bar.st = MISC + 8;
    if (hi - lo > 1) bar = xcd_barrier_post((unsigned*)(a.ws + WS_CTL), MISC + 8);
#define IN(k) in_range(lo, hi, (k))
#define SEAM(k) do { if (IN(k) && IN((k) + 1)) xcd_barrier<false>(bar); } while (0)
#define WSO() int cb = blockIdx.x, G = gridDim.x; asm volatile("" : "+s"(cb), "+s"(G)); F.G = G; F.vcu = (G % 8 == 0) ? (cb % 8) * (G / 8) + cb / 8 : cb; { int t_ = threadIdx.x; asm volatile("" : "+v"(t_)); F.tid = t_; F.lane = t_ & 63; F.wave = __builtin_amdgcn_readfirstlane(t_ >> 6); } size_t z_ = 0; asm volatile("" : "+s"(z_)); unsigned char* ws = a.ws + z_; bf16_t* XN = (bf16_t*)(ws + WS_XN); float* H = (float*)(ws + WS_H); const unsigned char* wl = ws + WS_W + (size_t)l * W_LAYER; (void)XN; (void)H; (void)wl; (void)cb

    if (IN(0)) EN(0) DUP(0) {
        const int l = 0; WSO();
        p_prologue(F, a);
        const int gw = F.vcu * 8 + F.wave, NGW = F.G * 8;
        for (int t = gw; t < T; t += NGW) rms_row(a.in[I_X] + (size_t)t * DM, a.in[I_NMIX], XN + (size_t)t * DM, F.lane);
    }
    if (hi - lo > 1) xcd_barrier<true>(bar);
#pragma unroll 1
    for (int l = 0; l < DEPTH; ++l) {
        const int P = 1 + 10 * l;
        if (IN(P + 0)) EN(1) DUP(1) {
            WSO();
            const Shape g{DM, DM, DM, 128u * DM * 2u};
            const SchedGrid S{(const char*)XN, (const char*)(wl + WO_IN), (size_t)256 * DM * 2, (size_t)256 * DM * 2, 64, NIN / 256, G, cb};
            const EpiInProj E{(bf16_t*)(ws + WS_QNA), (bf16_t*)(ws + WS_KNA), (bf16_t*)(ws + WS_VT), (bf16_t*)(ws + WS_UF), (bf16_t*)(ws + WS_GATES), (bf16_t*)(ws + WS_CQ), (bf16_t*)(ws + WS_CKV), (bf16_t*)(ws + WS_KPE),
                              a.in[I_BGATE] + (size_t)l * 6144, (const float*)(ws + WS_ROPEC), (const float*)(ws + WS_ROPES), (float*)(ws + WS_SSQQ), (float*)(ws + WS_SSQKV)};
            pg8::gemm_phase<EpiInProj, SchedGrid, false>(F.lds, g, S, E);
        }
        SEAM(P + 0);
        if (IN(P + 1)) DUP(2) {
            EN(2) { WSO(); const Shape g{256, 256, 1024, 128u * 1024u * 2u}; const SchedF1 S{(const char*)(ws + WS_WCH), (const char*)(ws + WS_UF), G, F.vcu}; const EpiF1 E{(bf16_t*)(ws + WS_ZT)};
              pg8::gemm_phase<EpiF1, SchedF1, false>(F.lds, g, S, E); }
            EN(3) { WSO(); const Shape g{QLP, QLP, QLP, 128u * QLP * 2u}; const SchedGrid S{(const char*)(ws + WS_CQ), (const char*)(wl + WO_UQ), (size_t)256 * QLP * 2, (size_t)256 * QLP * 2, 64, 6, G, cb};
              const EpiQup E{(bf16_t*)(ws + WS_QMLA), (const float*)(ws + WS_SSQQ), (const float*)(ws + WS_ROPEC), (const float*)(ws + WS_ROPES)};
              pg8::gemm_phase<EpiQup, SchedGrid, false>(F.lds, g, S, E); }
            EN(4) { WSO(); const Shape g{KVLP, KVLP, KVLP, 128u * KVLP * 2u}; const SchedGrid S{(const char*)(ws + WS_CKV), (const char*)(wl + WO_UKV), (size_t)256 * KVLP * 2, (size_t)256 * KVLP * 2, 64, 8, G, cb};
              const EpiKVup E{(bf16_t*)(ws + WS_KVMLA), (const float*)(ws + WS_SSQKV)};
              pg8::gemm_phase<EpiKVup, SchedGrid, false>(F.lds, g, S, E); }
            EN(5) { WSO(); na_phase(F, a.in[I_RPB] + (size_t)l * 16 * 15 * 31, (const bf16_t*)(ws + WS_QNA), (const bf16_t*)(ws + WS_KNA), (const bf16_t*)(ws + WS_VT), (bf16_t*)(ws + WS_YNA)); }
        }
        SEAM(P + 1);
        if (IN(P + 2)) DUP(3) {
            EN(6) { WSO(); const Shape g{8192, 8192, 8192, 128u * 8192u * 2u}; const SchedDft S{(const char*)(ws + WS_ADFT), (const char*)(ws + WS_ZT), F.vcu}; const EpiBf16 E{(bf16_t*)(ws + WS_YF), 1024};
              pg8::gemm_phase<EpiBf16, SchedDft, false>(F.lds, g, S, E); }
            EN(7) for (int uidx = F.vcu; uidx < 512; uidx += F.G) {
                WSO();
                const int qb = uidx & 15, h = (uidx >> 4) & 7, b = uidx >> 7;
                const bf16_t* kv = (const bf16_t*)(ws + WS_KVMLA) + (size_t)b * SEQ * 2048 + h * 256;
                mla::attn_body((const bf16_t*)(ws + WS_QMLA) + ((size_t)b * SEQ + qb * 256) * 1536 + h * 192, kv, kv + 128, (const bf16_t*)(ws + WS_KPE) + (size_t)b * SEQ * 64,
                               (bf16_t*)(ws + WS_YMLA) + ((size_t)b * SEQ + qb * 256) * 1024 + h * 128, SEQ, (char*)lds);
            }
        }
        SEAM(P + 2);
        if (IN(P + 3)) EN(8) DUP(4) {
            WSO();
            const Shape g{1024, 1024, 1024, 128u * 1024u * 2u};
            const SchedBranch S{{(const char*)(ws + WS_YNA), (const char*)(ws + WS_YMLA), (const char*)(ws + WS_YF)}, (const char*)(wl + WO_BR), G, cb};
            const EpiBranch E{(const bf16_t*)(ws + WS_GATES), (bf16_t*)(ws + WS_MERGED)};
            pg8::gemm_phase<EpiBranch, SchedBranch, false>(F.lds, g, S, E);
        }
        SEAM(P + 3);
        if (IN(P + 4)) EN(9) {
            WSO();
            const Shape g{DM, DM, DM, 128u * DM * 2u};
            const SchedGrid S{(const char*)(ws + WS_MERGED), (const char*)(wl + WO_O), (size_t)256 * DM * 2, (size_t)256 * DM * 2, 64, 8, G, cb};
            const EpiResid E{l == 0 ? a.in[I_X] : (const float*)H, H};
            pg8::gemm_phase<EpiResid, SchedGrid, false>(F.lds, g, S, E);
        }
        SEAM(P + 4);
        if (IN(P + 5)) EN(10) DUP(6) { WSO(); router_phase(F, H, a.in[I_NMOE] + (size_t)l * DM, a.in[I_WROUTER] + (size_t)l * DM * NE, XN, (float*)(ws + WS_AFF)); }
        SEAM(P + 5);
        if (IN(P + 6)) EN(11) DUP(7) { WSO(); if (F.vcu < NB * NE) topk_unit(F, (const float*)(ws + WS_AFF), F.vcu >> 4, F.vcu & 15, (int*)(ws + WS_MROWS), (float*)(ws + WS_MGATE), (int*)(ws + WS_SLOT)); }
        SEAM(P + 6);
        if (IN(P + 7)) EN(12) DUP(8) {
            WSO();
            const Shape g{DM, DM, DM, (unsigned)(FF * DM * 2)};
            const SchedMoe1 S{(const char*)XN, (const int*)(ws + WS_MROWS), (const char*)(wl + WO_GU), G, F.vcu};
            const EpiSwiglu E{(bf16_t*)(ws + WS_HMOE)};
            pg8::gemm_phase<EpiSwiglu, SchedMoe1, true>(F.lds, g, S, E);
        }
        SEAM(P + 7);
        if (IN(P + 8)) EN(13) DUP(9) {
            WSO();
            const Shape g{FF, FF, FF, 128u * FF * 2u};
            const SchedMoe2 S{(const char*)(ws + WS_HMOE), (const char*)(wl + WO_D), G, F.vcu};
            const EpiDown E{(bf16_t*)(ws + WS_YE), (const float*)(ws + WS_MGATE)};
            pg8::gemm_phase<EpiDown, SchedMoe2, false>(F.lds, g, S, E);
        }
        SEAM(P + 8);
        if (IN(P + 9)) EN(14) {
            WSO();
            if (l + 1 < DEPTH) combine_phase(F, H, (const bf16_t*)(ws + WS_YE), (const int*)(ws + WS_SLOT), a.in[I_NMIX] + (size_t)(l + 1) * DM, XN, nullptr);
            else combine_phase(F, H, (const bf16_t*)(ws + WS_YE), (const int*)(ws + WS_SLOT), a.in[I_NFINAL], nullptr, a.out);
        }
        SEAM(P + 9);
    }
#undef IN
#undef SEAM
}


#if MK_DEBUG
__device__ __forceinline__ unsigned hsh(unsigned x) { x ^= x >> 16; x *= 0x7feb352dU; x ^= x >> 15; x *= 0x846ca68bU; x ^= x >> 16; return x; }
__device__ __forceinline__ float bfr(float f) { return __uint_as_float(f2bf(f) << 16); }
__device__ __forceinline__ void rep(unsigned char* ws, int id, double got, double ex, double rel, double ab) { const double err = fabs(got - ex); if (!(err <= rel * fabs(ex) + ab)) ((int*)(ws + WS_DBG))[id] = 1; }
#define WSB(off) ((const bf16_t*)(ws + (off)))
#define WSF(off) ((const float*)(ws + (off)))
__device__ int inproj_dst2src(int n) {
    if (n < 3072) return n; if (n < 4096) return 3744 + (n - 3072); if (n < 10240) return 4768 + (n - 4096); if (n < 10688) return 3072 + (n - 10240); if (n < 10752) return -1;
    if (n < 10912) return 3520 + (n - 10752); if (n < 10976) { const int i = n - 10912; return 3680 + (i >> 1) + 32 * (i & 1); } return -1; }
__global__ void chk_prologue(Args a) {
    unsigned char* ws = a.ws; const unsigned i = blockIdx.x * blockDim.x + threadIdx.x; const unsigned r = hsh(i * 7 + 1), r2 = hsh(r + 12345);
    for (int l = 0; l < DEPTH; ++l) { const unsigned char* wl = ws + WS_W + (size_t)l * W_LAYER;
        { const int n = r % NIN, k = r2 % DM, sc = inproj_dst2src(n); const float ex = sc < 0 ? 0.f : bfr(a.in[I_WIN][((size_t)l * DM + k) * IN_COLS + sc]); rep(ws, 1, bf2f(((const bf16_t*)(wl + WO_IN))[(size_t)n * DM + k]), ex, 0, 1e-12); }
        { const int n = r % 1536, k = r2 % QLP, h = n / 192, c = n % 192; int sc = n; if (c >= 128) { const int ii = c - 128; sc = h * 192 + 128 + (ii >> 1) + 32 * (ii & 1); }
          const float ex = k < QL ? bfr(a.in[I_WUQ][((size_t)l * QL + k) * 1536 + sc] * a.in[I_QNORM][l * QL + k]) : 0.f; rep(ws, 2, bf2f(((const bf16_t*)(wl + WO_UQ))[(size_t)n * QLP + k]), ex, 0, 1e-12); }
        { const int n = r % 2048, k = r2 % KVLP; const float ex = k < KVL ? bfr(a.in[I_WUKV][((size_t)l * KVL + k) * 2048 + n] * a.in[I_KVNORM][l * KVL + k]) : 0.f; rep(ws, 3, bf2f(((const bf16_t*)(wl + WO_UKV))[(size_t)n * KVLP + k]), ex, 0, 1e-12); }
        { const int br = r % 3, n = (r >> 2) % DM, k = r2 % 1024; rep(ws, 4, bf2f(((const bf16_t*)(wl + WO_BR))[((size_t)br * DM + n) * 1024 + k]), bfr(a.in[I_WBR][(((size_t)l * 3 + br) * 1024 + k) * DM + n]), 0, 1e-12); }
        { const int n = r % DM, k = r2 % DM; rep(ws, 5, bf2f(((const bf16_t*)(wl + WO_O))[(size_t)n * DM + k]), bfr(a.in[I_WO][((size_t)l * DM + k) * DM + n]), 0, 1e-12); }
        { const int e = r % NE, f = (r >> 4) % FF, d = r2 % DM;
          rep(ws, 6, bf2f(((const bf16_t*)(wl + WO_GU))[(((size_t)e * 2) * FF + f) * DM + d]), bfr(a.in[I_WG][(((size_t)l * NE + e) * DM + d) * FF + f]), 0, 1e-12);
          rep(ws, 6, bf2f(((const bf16_t*)(wl + WO_GU))[(((size_t)e * 2 + 1) * FF + f) * DM + d]), bfr(a.in[I_WU][(((size_t)l * NE + e) * DM + d) * FF + f]), 0, 1e-12);
          rep(ws, 7, bf2f(((const bf16_t*)(wl + WO_D))[((size_t)e * DM + d) * FF + f]), bfr(a.in[I_WD][(((size_t)l * NE + e) * FF + f) * DM + d]), 0, 1e-12); } }
    { const int t = r % T, c = r2 % DM; double ss = 0; for (int k = 0; k < DM; ++k) { const double x = a.in[I_X][(size_t)t * DM + k]; ss += x * x; }
      const double ex = a.in[I_X][(size_t)t * DM + c] / sqrt(ss / DM + 1e-6) * a.in[I_NMIX][c]; rep(ws, 8, bf2f(WSB(WS_XN)[(size_t)t * DM + c]), ex, 0.006, 1e-3); }
    { const int sp = r % SEQ, j = r2 % 32; const float inv = 1.0f / powf(10000.0f, (float)(2 * j) / 64.0f); const float ang = (float)sp * inv;
      rep(ws, 9, WSF(WS_ROPEC)[sp * 32 + j], cos((double)ang), 0, 2e-3); rep(ws, 9, WSF(WS_ROPES)[sp * 32 + j], sin((double)ang), 0, 2e-3);
      const int k = r % 4096, n = r2 % 8192; const double ph = 2.0 * M_PI * (double)(((long)k * (n & 4095)) % 4096) / 4096.0;
      rep(ws, 9, bf2f(WSB(WS_ADFT)[(size_t)k * 8192 + n]), (n < 4096 ? cos(ph) : -sin(ph)) / 64.0, 0.006, 1e-4);
      const int rr = r % 512, jj = r2 % 256; const double p2 = 2.0 * M_PI * (double)(((rr & 255) * jj) % 256) / 256.0;
      rep(ws, 9, bf2f(WSB(WS_WCH)[rr * 256 + jj]), (rr < 256 ? cos(p2) : sin(p2)) / 16.0, 0.006, 3e-4); }
}
__device__ double inproj_dot(const Args& a, int l, int t, int col) { const bf16_t* xr = (const bf16_t*)(a.ws + WS_XN) + (size_t)t * DM; const float* w = a.in[I_WIN] + (size_t)l * DM * IN_COLS + col; double s = 0;
    for (int k = 0; k < DM; ++k) s += (double)bf2f(xr[k]) * (double)bfr(w[(size_t)k * IN_COLS]); return s; }
__global__ void chk_inproj(Args a, int l) {
    unsigned char* ws = a.ws; const unsigned i = blockIdx.x * blockDim.x + threadIdx.x; const unsigned r = hsh(i * 3 + 77 + l), r2 = hsh(r + 999);
    const int t = r % T, b = t >> 12, sp = t & 4095; const int seg = i & 7; const int B10 = l * 45 + 10;
    if (seg == 0) { const int c = r2 % 1024; rep(ws, B10 + 0, bf2f(WSB(WS_QNA)[(size_t)t * 1024 + c]), inproj_dot(a, l, t, c) * 0.125, 0.01, 0.01); }
    else if (seg == 1) { const int c = r2 % 1024; rep(ws, B10 + 1, bf2f(WSB(WS_KNA)[(size_t)t * 1024 + c]), inproj_dot(a, l, t, 1024 + c), 0.01, 0.02); }
    else if (seg == 2) { const int c = r2 % 1024; rep(ws, B10 + 2, bf2f(WSB(WS_VT)[((size_t)(b * 16 + (c >> 6)) * 64 + (c & 63)) * SEQ + sp]), inproj_dot(a, l, t, 2048 + c), 0.01, 0.02); }
    else if (seg == 3) { const int c = r2 % QLP; rep(ws, B10 + 3, bf2f(WSB(WS_CQ)[(size_t)t * QLP + c]), c < QL ? inproj_dot(a, l, t, 3072 + c) : 0.0, 0.01, c < QL ? 0.02 : 0.0); }
    else if (seg == 4) { const int c = r2 % KVLP; rep(ws, B10 + 4, bf2f(WSB(WS_CKV)[(size_t)t * KVLP + c]), c < KVL ? inproj_dot(a, l, t, 3520 + c) : 0.0, 0.01, c < KVL ? 0.02 : 0.0); }
    else if (seg == 5) { const int jj = r2 % 32; const double x1 = inproj_dot(a, l, t, 3680 + jj), x2 = inproj_dot(a, l, t, 3680 + 32 + jj);
        const float inv = 1.0f / powf(10000.0f, (float)(2 * jj) / 64.0f); const double ang = (double)((float)sp * inv), cs = cos(ang), sn = sin(ang);
        rep(ws, B10 + 5, bf2f(WSB(WS_KPE)[(size_t)t * 64 + 2 * jj]), x1 * cs - x2 * sn, 0.01, 0.03); rep(ws, B10 + 5, bf2f(WSB(WS_KPE)[(size_t)t * 64 + 2 * jj + 1]), x2 * cs + x1 * sn, 0.01, 0.03); }
    else if (seg == 6) { const int c = r2 % 1024; rep(ws, B10 + 6, bf2f(WSB(WS_UF)[(size_t)t * 1024 + c]), inproj_dot(a, l, t, 3744 + c), 0.01, 0.02); }
    else { const int c = r2 % 6144; const double z = inproj_dot(a, l, t, 4768 + c) + a.in[I_BGATE][l * 6144 + c]; rep(ws, B10 + 7, bf2f(WSB(WS_GATES)[(size_t)t * 6144 + c]), 1.0 / (1.0 + exp(-z)), 0.01, 0.01);
        double sq = 0, skv = 0; for (int k = 0; k < QL; ++k) { const double x = bf2f(WSB(WS_CQ)[(size_t)t * QLP + k]); sq += x * x; } for (int k = 0; k < KVL; ++k) { const double x = bf2f(WSB(WS_CKV)[(size_t)t * KVLP + k]); skv += x * x; }
        double pq = 0, pkv = 0; for (int k = 0; k < 8; ++k) pq += WSF(WS_SSQQ)[(size_t)t * 8 + k]; for (int k = 0; k < 4; ++k) pkv += WSF(WS_SSQKV)[(size_t)t * 4 + k];
        rep(ws, B10 + 8, pq, sq, 0.02, 1e-3); rep(ws, B10 + 8, pkv, skv, 0.02, 1e-3); }
}
__global__ void chk_mid(Args a, int l) {
    unsigned char* ws = a.ws; const unsigned i = blockIdx.x * blockDim.x + threadIdx.x; const unsigned r = hsh(i * 5 + 31 + l), r2 = hsh(r + 4242);
    const int seg = i & 3; const int B20 = l * 45 + 20; const int t = r % T, b = t >> 12, sp = t & 4095;
    if (seg == 0) {
        const int g = r2 & 3, c = (r2 >> 2) & 255, part = (r2 >> 10) & 1; double s = 0;
        for (int j = 0; j < 256; ++j) { const double ph = 2.0 * M_PI * (double)((c * j) % 256) / 256.0; s += (double)bf2f(WSB(WS_UF)[(size_t)t * 1024 + g * 256 + j]) * (part ? sin(ph) : cos(ph)); }
        rep(ws, B20 + 0, bf2f(WSB(WS_ZT)[((size_t)b * 1024 + g * 256 + c) * 8192 + part * 4096 + sp]), s / 16.0, 0.015, 0.02);
    } else if (seg == 1) {
        const int h = r2 & 7, jj = (r2 >> 3) % 96; double ss = 0; for (int k = 0; k < QL; ++k) { const double x = bf2f(WSB(WS_CQ)[(size_t)t * QLP + k]); ss += x * x; } const double rstd = 1.0 / sqrt(ss / QL + 1e-6);
        auto qd = [&](int col) { double s = 0; for (int k = 0; k < QL; ++k) s += (double)bf2f(WSB(WS_CQ)[(size_t)t * QLP + k]) * (double)bfr(a.in[I_WUQ][((size_t)l * QL + k) * 1536 + col] * a.in[I_QNORM][l * QL + k]); return s * rstd; };
        if (jj < 64) { const int c = jj * 2 + (r2 >> 20 & 1); rep(ws, B20 + 1, bf2f(WSB(WS_QMLA)[(size_t)t * 1536 + h * 192 + c]), qd(h * 192 + c), 0.015, 0.03); }
        else { const int j = jj - 64; const double x1 = qd(h * 192 + 128 + j), x2 = qd(h * 192 + 160 + j); const float inv = 1.0f / powf(10000.0f, (float)(2 * j) / 64.0f); const double ang = (double)((float)sp * inv), cs = cos(ang), sn = sin(ang);
            rep(ws, B20 + 1, bf2f(WSB(WS_QMLA)[(size_t)t * 1536 + h * 192 + 128 + 2 * j]), x1 * cs - x2 * sn, 0.015, 0.04); rep(ws, B20 + 1, bf2f(WSB(WS_QMLA)[(size_t)t * 1536 + h * 192 + 128 + 2 * j + 1]), x2 * cs + x1 * sn, 0.015, 0.04); }
    } else if (seg == 2) {
        const int n = r2 % 2048; double ss = 0; for (int k = 0; k < KVL; ++k) { const double x = bf2f(WSB(WS_CKV)[(size_t)t * KVLP + k]); ss += x * x; } const double rstd = 1.0 / sqrt(ss / KVL + 1e-6);
        double s = 0; for (int k = 0; k < KVL; ++k) s += (double)bf2f(WSB(WS_CKV)[(size_t)t * KVLP + k]) * (double)bfr(a.in[I_WUKV][((size_t)l * KVL + k) * 2048 + n] * a.in[I_KVNORM][l * KVL + k]);
        rep(ws, B20 + 2, bf2f(WSB(WS_KVMLA)[(size_t)t * 2048 + n]), s * rstd, 0.015, 0.03);
    } else {
        const int h = r2 & 15, d = (r2 >> 4) & 63, gr = sp >> 6, gc = sp & 63;
        int rs = gr - 4; rs = rs < 0 ? 0 : (rs > 56 ? 56 : rs); int cs0 = gc - 8; cs0 = cs0 < 0 ? 0 : (cs0 > 48 ? 48 : cs0);
        double mx = -1e300, sum = 0, o = 0;
        for (int pass = 0; pass < 2; ++pass)
        for (int ii = 0; ii < 8; ++ii) for (int jj = 0; jj < 16; ++jj) { const int kr = rs + ii, kc = cs0 + jj, tk = b * SEQ + kr * 64 + kc; double s = 0;
            for (int dd = 0; dd < 64; ++dd) s += (double)bf2f(WSB(WS_QNA)[(size_t)t * 1024 + h * 64 + dd]) * (double)bf2f(WSB(WS_KNA)[(size_t)tk * 1024 + h * 64 + dd]);
            int ci = kc - gc + 15; ci = ci < 0 ? 0 : (ci > 30 ? 30 : ci);
            s += (double)a.in[I_RPB][(((size_t)l * 16 + h) * 15 + (kr - gr + 7)) * 31 + ci];
            if (pass == 0) mx = s > mx ? s : mx;
            else { const double p = exp(s - mx); sum += p; o += p * (double)bf2f(WSB(WS_VT)[((size_t)(b * 16 + h) * 64 + d) * SEQ + kr * 64 + kc]); } }
        rep(ws, B20 + 3, bf2f(WSB(WS_YNA)[(size_t)t * 1024 + h * 64 + d]), o / sum, 0.02, 0.01);
    }
}
__global__ void chk_dft_mla(Args a, int l) {
    unsigned char* ws = a.ws; __shared__ double red[256]; __shared__ double red2[256];
    const unsigned r = hsh(blockIdx.x * 11 + 5 + l), r2 = hsh(r + 777); const int tid = threadIdx.x; const int B25 = l * 45 + 25;
    if (blockIdx.x < 64) {
        const int b = r & 3, k = (r >> 2) & 4095, g = (r >> 14) & 3, c = r2 & 255; double s = 0;
        for (int n = tid; n < SEQ; n += 256) { const int pk = (k * n) & 4095; const bf16_t* up = WSB(WS_UF) + ((size_t)b * SEQ + n) * 1024 + g * 256;
            for (int j = 0; j < 256; ++j) { const int ph = (pk + 16 * ((c * j) & 255)) & 4095; s += (double)bf2f(up[j]) * cospi((double)ph / 2048.0); } }
        red[tid] = s; __syncthreads(); for (int o = 128; o > 0; o >>= 1) { if (tid < o) red[tid] += red[tid + o]; __syncthreads(); }
        if (tid == 0) rep(ws, B25 + 0, bf2f(WSB(WS_YF)[((size_t)b * SEQ + k) * 1024 + g * 256 + c]), red[0] / 1024.0, 0.03, 0.03);
    } else {
        const int b = r & 3, q = (r >> 2) & 4095, h = (r >> 14) & 7, d = r2 & 127; const size_t tq = (size_t)b * SEQ + q;
        double sc[16], mx = -1e300;
        for (int kk = 0; kk < 16; ++kk) { const size_t tk = (size_t)b * SEQ + tid + 256 * kk; double s = 0;
            for (int dd = 0; dd < 128; ++dd) s += (double)bf2f(WSB(WS_QMLA)[tq * 1536 + h * 192 + dd]) * (double)bf2f(WSB(WS_KVMLA)[tk * 2048 + h * 256 + dd]);
            for (int dd = 0; dd < 64; ++dd) s += (double)bf2f(WSB(WS_QMLA)[tq * 1536 + h * 192 + 128 + dd]) * (double)bf2f(WSB(WS_KPE)[tk * 64 + dd]);
            sc[kk] = s * 0.07216878364870322; mx = sc[kk] > mx ? sc[kk] : mx; }
        red[tid] = mx; __syncthreads(); for (int o = 128; o > 0; o >>= 1) { if (tid < o) red[tid] = red[tid] > red[tid + o] ? red[tid] : red[tid + o]; __syncthreads(); }
        const double gm = red[0]; __syncthreads(); double sum = 0, o = 0;
        for (int kk = 0; kk < 16; ++kk) { const size_t tk = (size_t)b * SEQ + tid + 256 * kk; const double p = exp(sc[kk] - gm); sum += p; o += p * (double)bf2f(WSB(WS_KVMLA)[tk * 2048 + h * 256 + 128 + d]); }
        red[tid] = sum; red2[tid] = o; __syncthreads(); for (int oo = 128; oo > 0; oo >>= 1) { if (tid < oo) { red[tid] += red[tid + oo]; red2[tid] += red2[tid + oo]; } __syncthreads(); }
        if (tid == 0) rep(ws, B25 + 1, bf2f(WSB(WS_YMLA)[tq * 1024 + h * 128 + d]), red2[0] / red[0], 0.02, 0.002);
    }
}
__global__ void dbg_save_h(Args a, int which, int l) {
    unsigned char* ws = a.ws; const unsigned i = blockIdx.x * blockDim.x + threadIdx.x; const unsigned r = hsh(i * 13 + 3 + l + which * 1000), r2 = hsh(r + 555);
    const int t = r % T, c = r2 % DM; ((float*)(ws + WS_DBG + 65536))[which * 4096 + i] = (which == 0 && l == 0) ? a.in[I_X][(size_t)t * DM + c] : WSF(WS_H)[(size_t)t * DM + c];
}
__global__ void chk_merge_wo(Args a, int l, int which) {
    unsigned char* ws = a.ws; const unsigned i = blockIdx.x * blockDim.x + threadIdx.x; const int B27 = l * 45 + 27;
    if (which == 0) { const unsigned r = hsh(i * 17 + 9 + l), r2 = hsh(r + 321); const int t = r % T, n = r2 % DM; double m = 0;
        const size_t yo[3] = {WS_YNA, WS_YMLA, WS_YF};
        for (int br = 0; br < 3; ++br) { double s = 0; for (int k = 0; k < 1024; ++k) s += (double)bf2f(WSB(yo[br])[(size_t)t * 1024 + k]) * (double)bfr(a.in[I_WBR][(((size_t)l * 3 + br) * 1024 + k) * DM + n]);
            m += s * (double)bf2f(WSB(WS_GATES)[(size_t)t * 6144 + br * 2048 + n]); }
        rep(ws, B27 + 0, bf2f(WSB(WS_MERGED)[(size_t)t * DM + n]), m, 0.015, 0.01);
    } else { const unsigned r = hsh(i * 13 + 3 + l + 0 * 1000), r2 = hsh(r + 555); const int t = r % T, c = r2 % DM; double s = 0;
        for (int k = 0; k < DM; ++k) s += (double)bf2f(WSB(WS_MERGED)[(size_t)t * DM + k]) * (double)bfr(a.in[I_WO][((size_t)l * DM + k) * DM + c]);
        rep(ws, B27 + 1, WSF(WS_H)[(size_t)t * DM + c], (double)((const float*)(ws + WS_DBG + 65536))[i] + s, 0.002, 0.005); }
}
__global__ void chk_router(Args a, int l) {
    unsigned char* ws = a.ws; const unsigned i = blockIdx.x * blockDim.x + threadIdx.x; const unsigned r = hsh(i * 19 + 2 + l), r2 = hsh(r + 88); const int B29 = l * 45 + 29;
    const int t = r % T, c = r2 % DM; double ss = 0; for (int k = 0; k < DM; ++k) { const double x = WSF(WS_H)[(size_t)t * DM + k]; ss += x * x; } const double rstd = 1.0 / sqrt(ss / DM + 1e-6);
    rep(ws, B29 + 0, bf2f(WSB(WS_XN)[(size_t)t * DM + c]), WSF(WS_H)[(size_t)t * DM + c] * rstd * a.in[I_NMOE][l * DM + c], 0.006, 1e-3);
    double lg[16], mx = -1e300; for (int e = 0; e < 16; ++e) { double s = 0; for (int k = 0; k < DM; ++k) s += WSF(WS_H)[(size_t)t * DM + k] * rstd * a.in[I_NMOE][l * DM + k] * (double)a.in[I_WROUTER][((size_t)l * DM + k) * NE + e]; lg[e] = s; mx = s > mx ? s : mx; }
    double sum = 0; for (int e = 0; e < 16; ++e) { lg[e] = exp(lg[e] - mx); sum += lg[e]; }
    for (int e = 0; e < 16; ++e) rep(ws, B29 + 1, WSF(WS_AFF)[((size_t)(t >> 12) * NE + e) * SEQ + (t & 4095)], lg[e] / sum, 1e-4, 1e-6);
}
__global__ void chk_topk(Args a, int l) {
    unsigned char* ws = a.ws; const int be = blockIdx.x * blockDim.x + threadIdx.x; if (be >= NB * NE) return; const int b = be >> 4, e = be & 15; const int id = l * 45 + 31;
    const float* af = WSF(WS_AFF) + (size_t)be * SEQ; const int* so = (const int*)(ws + WS_SLOT); const int* mr = (const int*)(ws + WS_MROWS); const float* mg = WSF(WS_MGATE);
    int cnt = 0; float mins = 1e30f, maxu = -1.f; int bad = 0;
    for (int sp = 0; sp < SEQ; ++sp) { const int sl = so[(size_t)(b * SEQ + sp) * NE + e];
        if (sl >= 0) { ++cnt; mins = fminf(mins, af[sp]); if (sl < b * CAP || sl >= (b + 1) * CAP) bad = 1; else { if (mr[e * ROWS_E + sl] != b * SEQ + sp) bad = 1; if (mg[e * ROWS_E + sl] != af[sp]) bad = 1; } }
        else maxu = fmaxf(maxu, af[sp]); }
    if (cnt != CAP || bad || !(mins >= maxu)) ((int*)(ws + WS_DBG))[id] = 1;
}
__global__ void chk_moe(Args a, int l, int which) {
    unsigned char* ws = a.ws; const unsigned i = blockIdx.x * blockDim.x + threadIdx.x; const unsigned r = hsh(i * 23 + 6 + l + which), r2 = hsh(r + 1111); const int B32 = l * 45 + 32;
    const int e = r & 15, row = (r >> 4) % ROWS_E;
    if (which == 0) { const int f = r2 % FF, tok = ((const int*)(ws + WS_MROWS))[e * ROWS_E + row]; double g = 0, u = 0;
        for (int k = 0; k < DM; ++k) { const double x = bf2f(WSB(WS_XN)[(size_t)tok * DM + k]); g += x * (double)bfr(a.in[I_WG][(((size_t)l * NE + e) * DM + k) * FF + f]); u += x * (double)bfr(a.in[I_WU][(((size_t)l * NE + e) * DM + k) * FF + f]); }
        rep(ws, B32 + 0, bf2f(WSB(WS_HMOE)[((size_t)e * ROWS_E + row) * FF + f]), g / (1.0 + exp(-g)) * u, 0.02, 0.01);
    } else { const int d = r2 % DM; double s = 0; for (int f = 0; f < FF; ++f) s += (double)bf2f(WSB(WS_HMOE)[((size_t)e * ROWS_E + row) * FF + f]) * (double)bfr(a.in[I_WD][(((size_t)l * NE + e) * FF + f) * DM + d]);
        rep(ws, B32 + 1, bf2f(WSB(WS_YE)[((size_t)e * ROWS_E + row) * DM + d]), s * WSF(WS_MGATE)[e * ROWS_E + row], 0.02, 0.003); }
}
__global__ void chk_combine(Args a, int l) {
    unsigned char* ws = a.ws; const unsigned i = blockIdx.x * blockDim.x + threadIdx.x; const unsigned r = hsh(i * 13 + 3 + l + 1 * 1000), r2 = hsh(r + 555); const int B34 = l * 45 + 34;
    const int t = r % T, c = r2 % DM; double s = ((const float*)(ws + WS_DBG + 65536))[4096 + i];
    for (int e = 0; e < NE; ++e) { const int sl = ((const int*)(ws + WS_SLOT))[(size_t)t * NE + e]; if (sl >= 0) s += (double)bf2f(WSB(WS_YE)[((size_t)e * ROWS_E + sl) * DM + c]); }
    rep(ws, B34 + 0, WSF(WS_H)[(size_t)t * DM + c], s, 1e-4, 1e-4);
    double ss = 0; for (int k = 0; k < DM; ++k) { const double x = WSF(WS_H)[(size_t)t * DM + k]; ss += x * x; } const double rstd = 1.0 / sqrt(ss / DM + 1e-6);
    if (l + 1 < DEPTH) rep(ws, B34 + 1, bf2f(WSB(WS_XN)[(size_t)t * DM + c]), WSF(WS_H)[(size_t)t * DM + c] * rstd * a.in[I_NMIX][(l + 1) * DM + c], 0.006, 1e-3);
    else rep(ws, B34 + 1, a.out[(size_t)t * DM + c], WSF(WS_H)[(size_t)t * DM + c] * rstd * a.in[I_NFINAL][c], 1e-4, 1e-5);
}
__global__ void dbg_final(Args a) {
    const int* fl = (const int*)(a.ws + WS_DBG); int k = 0; for (int i = 1; i < 99; ++i) if (fl[i]) { k = i; break; }
    if (k == 0) return;
    const float al = sqrtf((float)k);
    for (size_t i = (size_t)blockIdx.x * blockDim.x + threadIdx.x; i < (size_t)T * DM; i += (size_t)gridDim.x * blockDim.x) a.out[i] = (hsh((unsigned)i) & 1) ? al : -al;
}
static void dbg_before_phase(int p, const Args& a, hipStream_t st) {
    if (p == 0) return; const int l = (p - 1) / 10, k = (p - 1) % 10;
    if (k == 4) hipLaunchKernelGGL(dbg_save_h, dim3(16), dim3(256), 0, st, a, 0, l);
    if (k == 9) hipLaunchKernelGGL(dbg_save_h, dim3(16), dim3(256), 0, st, a, 1, l);
}
static void dbg_after_phase(int p, const Args& a, hipStream_t st) {
    if (p == 0) { hipLaunchKernelGGL(chk_prologue, dim3(64), dim3(256), 0, st, a); return; }
    const int l = (p - 1) / 10, k = (p - 1) % 10;
    if (k == 0) hipLaunchKernelGGL(chk_inproj, dim3(32), dim3(256), 0, st, a, l);
    if (k == 1) hipLaunchKernelGGL(chk_mid, dim3(32), dim3(256), 0, st, a, l);
    if (k == 2) hipLaunchKernelGGL(chk_dft_mla, dim3(128), dim3(256), 0, st, a, l);
    if (k == 3) hipLaunchKernelGGL(chk_merge_wo, dim3(16), dim3(256), 0, st, a, l, 0);
    if (k == 4) hipLaunchKernelGGL(chk_merge_wo, dim3(16), dim3(256), 0, st, a, l, 1);
    if (k == 5) hipLaunchKernelGGL(chk_router, dim3(8), dim3(256), 0, st, a, l);
    if (k == 6) hipLaunchKernelGGL(chk_topk, dim3(1), dim3(64), 0, st, a, l);
    if (k == 7) hipLaunchKernelGGL(chk_moe, dim3(16), dim3(256), 0, st, a, l, 0);
    if (k == 8) hipLaunchKernelGGL(chk_moe, dim3(16), dim3(256), 0, st, a, l, 1);
    if (k == 9) hipLaunchKernelGGL(chk_combine, dim3(16), dim3(256), 0, st, a, l);
}
static void dbg_finalize(const Args& a, hipStream_t st) { hipLaunchKernelGGL(dbg_final, dim3(1024), dim3(256), 0, st, a); }
#endif
extern "C" void kernel_launch(void* const* d_in, const int* in_sizes, int n_in, void* d_out, int out_size, void* d_ws, size_t ws_size, hipStream_t stream) {
    static int grid = 0;
    if (grid == 0) {
        if (n_in != 17 || out_size != T * DM || ws_size < WS_END) { fprintf(stderr, "kernel_launch: unexpected shapes (n_in %d out %d ws %zu)\n", n_in, out_size, ws_size); grid = -1; return; }
        int dev = 0, cus = 0, per_cu = 0;
        if (hipGetDevice(&dev) != hipSuccess || hipDeviceGetAttribute(&cus, hipDeviceAttributeMultiprocessorCount, dev) != hipSuccess) { grid = -1; return; }
        if (hipFuncSetAttribute((const void*)fwd, hipFuncAttributeMaxDynamicSharedMemorySize, LDS_BYTES) != hipSuccess) { fprintf(stderr, "kernel_launch: hipFuncSetAttribute failed\n"); grid = -1; return; }
        if (hipOccupancyMaxActiveBlocksPerMultiprocessor(&per_cu, (const void*)fwd, 512, LDS_BYTES) != hipSuccess || per_cu < 1) { fprintf(stderr, "kernel_launch: occupancy query says %d\n", per_cu); }
        (void)hipGetLastError();
        grid = cus;
    }
    if (grid < 0) return;
    (void)hipMemsetAsync((char*)d_ws + WS_CTL, 0, CTL_ZERO_BYTES, stream);
    Args a{};
    for (int i = 0; i < 17; ++i) a.in[i] = (const float*)d_in[i];
    a.out = (float*)d_out; a.ws = (unsigned char*)d_ws;
#if MK_DEBUG
    (void)hipMemsetAsync((char*)d_ws + WS_DBG, 0, 4096, stream);
    for (int p = 0; p < N_PHASES; ++p) {
        a.ph_lo = p; a.ph_hi = p + 1;
        dbg_before_phase(p, a, stream);
        hipLaunchKernelGGL(fwd, dim3(grid), dim3(512), LDS_BYTES, stream, a);
        dbg_after_phase(p, a, stream);
    }
    dbg_finalize(a, stream);
#else
    a.ph_lo = 0; a.ph_hi = N_PHASES;
    hipLaunchKernelGGL(fwd, dim3(grid), dim3(512), LDS_BYTES, stream, a);
#endif
}
```
